# Optimizing an MI355X kernel written in HIP

```python
import jax, jax.numpy as jnp
from jax import lax
import numpy as np

D_MODEL = 1024
BATCH = 8
SEQ = 4096
DEPTH = 2

N_META = 16
D_FF = 2816
EPS = 1e-6
POOL_WINDOWS = (2, 4, 8, 16)
POOL_GROUP = D_MODEL // 16
D_POOL = POOL_GROUP * len(POOL_WINDOWS)
HG_HEAD_K = 128
HG_HEAD_V = 128
D_HGRN = D_MODEL - D_POOL
HG_HEADS = D_HGRN // HG_HEAD_K
HG_CHUNK = 64
D_IN_EVEN = D_POOL + 4 * D_HGRN
D_CONV = D_MODEL // 2
CONV_WIDTH = 31
CONV_GROUPS = 4
D_LRU = D_MODEL // 2
LRU_HEADS = 8
LRU_HEAD = D_LRU // LRU_HEADS
LRU_CONV = 4
LRU_C = 8.0
D_IN_ODD = 2 * D_CONV + 2 * D_LRU
N_EVEN = (DEPTH + 1) // 2
N_ODD = DEPTH // 2

kernel_name = "hybrid_pool_hgrn2_conv_rglru_macaron"


def rms_norm(x, g):
    xf = x.astype(jnp.float32)
    y = xf * lax.rsqrt(jnp.mean(xf * xf, axis=-1, keepdims=True) + EPS)
    return (y * g.astype(jnp.float32)).astype(x.dtype)


def swiglu_ffn(x, wg, wu, wd):
    return (jax.nn.silu(x @ wg) * (x @ wu)) @ wd


def causal_depthwise_conv(x, w, b):
    width = w.shape[0]
    xp = jnp.pad(x, ((0, 0), (width - 1, 0), (0, 0)))
    y = lax.conv_general_dilated(xp, w.astype(x.dtype)[:, None, :], window_strides=(1,), padding='VALID',
                                 dimension_numbers=('NWC', 'WIO', 'NWC'), feature_group_count=x.shape[-1])
    return y + b.astype(x.dtype)


def multiscale_pool(u, w_grp, scale):
    bn, L, _ = u.shape
    ug = u.astype(jnp.float32).reshape(bn, L, len(POOL_WINDOWS), POOL_GROUP)
    c = jnp.cumsum(ug, axis=1)
    t = jnp.arange(1, L + 1, dtype=jnp.float32)[None, :, None]
    pooled = []
    for gi, w in enumerate(POOL_WINDOWS):
        cg = c[:, :, gi]
        lagged = jnp.pad(cg, ((0, 0), (w, 0), (0, 0)))[:, :L]
        pooled.append((cg - lagged) / jnp.minimum(t, float(w)))
    mixed = jnp.stack(pooled, axis=2) - ug
    y = jnp.einsum('blgc,gcd->blgd', mixed, w_grp.astype(jnp.float32))
    return (y.reshape(bn, L, D_POOL) * scale.astype(jnp.float32)).astype(u.dtype)


def hgrn2_mixer(q_raw, f_raw, i_raw, g_raw, lb, gnorm):
    f32 = jnp.float32
    bn, L, _ = q_raw.shape
    q = jax.nn.silu(q_raw.astype(f32))
    z = f_raw.astype(f32)
    lbf = lb.astype(f32)
    log_f = jnp.logaddexp(jnp.log(lbf), jnp.log1p(-lbf) + jax.nn.log_sigmoid(z))
    k = (1.0 - lbf) * jax.nn.sigmoid(-z)
    v = i_raw.astype(f32)
    pad = (-N_META) % HG_CHUNK
    n_chunks = (L + pad) // HG_CHUNK

    def to_chunks(a):
        a = jnp.pad(a, ((0, 0), (pad, 0), (0, 0)))
        return a.reshape(bn, n_chunks, HG_CHUNK, HG_HEADS, -1).transpose(1, 0, 3, 2, 4)

    causal = jnp.tril(jnp.ones((HG_CHUNK, HG_CHUNK), dtype=bool))[:, :, None]

    def step(S, inp):
        qc, kc, lfc, vc = inp
        b = jnp.cumsum(lfc, axis=2)
        o_inter = jnp.einsum('bhtk,bhkv->bhtv', qc * jnp.exp(b), S)
        diff = b[:, :, :, None, :] - b[:, :, None, :, :]
        decay = jnp.exp(jnp.where(causal, diff, -jnp.inf))
        A = jnp.einsum('bhtsk,bhsk->bhts', qc[:, :, :, None, :] * decay, kc)
        o = o_inter + jnp.einsum('bhts,bhsv->bhtv', A, vc)
        b_last = b[:, :, -1:, :]
        S_new = jnp.exp(b_last[:, :, 0, :])[..., None] * S + jnp.einsum('bhsk,bhsv->bhkv', kc * jnp.exp(b_last - b), vc)
        return S_new, o

    S0 = jnp.zeros((bn, HG_HEADS, HG_HEAD_K, HG_HEAD_V), f32)
    _, o = lax.scan(step, S0, (to_chunks(q), to_chunks(k), to_chunks(log_f), to_chunks(v)))
    o = o.transpose(1, 0, 3, 2, 4).reshape(bn, n_chunks * HG_CHUNK, HG_HEADS, HG_HEAD_V)[:, pad:]
    o = o * lax.rsqrt(jnp.mean(o * o, axis=-1, keepdims=True) + EPS) * gnorm.astype(f32)
    o = o * jax.nn.silu(g_raw.astype(f32)).reshape(bn, L, HG_HEADS, HG_HEAD_V)
    return o.reshape(bn, L, D_HGRN).astype(q_raw.dtype)


def conformer_conv_module(a, b, w, bias, ln_g, ln_b):
    f32 = jnp.float32
    bn, L, _ = a.shape
    u = a * jax.nn.sigmoid(b)
    u = causal_depthwise_conv(u, w, bias).astype(f32).reshape(bn, L, CONV_GROUPS, D_CONV // CONV_GROUPS)
    mu = jnp.mean(u, axis=-1, keepdims=True)
    var = jnp.mean(jnp.square(u - mu), axis=-1, keepdims=True)
    un = ((u - mu) * lax.rsqrt(var + EPS)).reshape(bn, L, D_CONV) * ln_g.astype(f32) + ln_b.astype(f32)
    return jax.nn.silu(un).astype(a.dtype)


def rglru_block(xb, gate, conv_w, conv_b, wa, ba, wx, bx, lam):
    f32 = jnp.float32
    u = causal_depthwise_conv(xb, conv_w, conv_b).astype(f32)
    bn, L, _ = u.shape
    uh = u.reshape(bn, L, LRU_HEADS, LRU_HEAD)
    r = jax.nn.sigmoid(jnp.einsum('blhi,hij->blhj', uh, wa.astype(f32)).reshape(bn, L, D_LRU) + ba.astype(f32))
    i = jax.nn.sigmoid(jnp.einsum('blhi,hij->blhj', uh, wx.astype(f32)).reshape(bn, L, D_LRU) + bx.astype(f32))
    log_a = -LRU_C * r * jax.nn.softplus(-lam.astype(f32))
    a = jnp.exp(log_a)
    mult = jnp.sqrt(-jnp.expm1(2.0 * log_a))
    reset = (jnp.arange(L) == 0)[None, :, None]
    bterm = jnp.where(reset, 1.0, mult) * (i * u)

    def combine(c1, c2):
        a1, b1 = c1
        a2, b2 = c2
        return a1 * a2, a2 * b1 + b2

    _, h = lax.associative_scan(combine, (a, bterm), axis=1)
    return (jax.nn.gelu(gate.astype(f32)) * h).astype(xb.dtype)


def setup_inputs(seed: int = 0) -> dict:
    key = jax.random.key(seed)
    ks = iter(jax.random.split(key, 48))
    f32 = jnp.float32

    def nrm(shape, scale):
        return jax.random.normal(next(ks), shape, f32) * scale

    def gain(shape):
        return 1.0 + 0.05 * jax.random.normal(next(ks), shape, f32)

    a0 = jax.random.uniform(next(ks), (N_ODD, D_LRU), f32, 0.9, 0.999)
    s = a0 ** (1.0 / LRU_C)
    lam = jnp.log(s) - jnp.log1p(-s)
    return {
        "x": nrm((BATCH, SEQ, D_MODEL), 1.0),
        "meta_tokens": nrm((N_META, D_MODEL), 1.0),
        "ffn1_norm": gain((DEPTH, D_MODEL)),
        "ffn1_wg": nrm((DEPTH, D_MODEL, D_FF), D_MODEL ** -0.5),
        "ffn1_wu": nrm((DEPTH, D_MODEL, D_FF), D_MODEL ** -0.5),
        "ffn1_wd": nrm((DEPTH, D_FF, D_MODEL), D_FF ** -0.5),
        "mix_norm": gain((DEPTH, D_MODEL)),
        "ffn2_norm": gain((DEPTH, D_MODEL)),
        "ffn2_wg": nrm((DEPTH, D_MODEL, D_FF), D_MODEL ** -0.5),
        "ffn2_wu": nrm((DEPTH, D_MODEL, D_FF), D_MODEL ** -0.5),
        "ffn2_wd": nrm((DEPTH, D_FF, D_MODEL), D_FF ** -0.5),
        "w_in_even": nrm((N_EVEN, D_MODEL, D_IN_EVEN), D_MODEL ** -0.5),
        "pool_w": nrm((N_EVEN, len(POOL_WINDOWS), POOL_GROUP, POOL_GROUP), POOL_GROUP ** -0.5),
        "pool_scale": gain((N_EVEN, D_POOL)),
        "hgrn_lb_logits": nrm((N_EVEN + 1, D_HGRN), 0.5),
        "hgrn_gnorm": gain((N_EVEN, HG_HEAD_V)),
        "w_out_even": nrm((N_EVEN, D_POOL + D_HGRN, D_MODEL), (D_POOL + D_HGRN) ** -0.5),
        "w_in_odd": nrm((N_ODD, D_MODEL, D_IN_ODD), D_MODEL ** -0.5),
        "conv_w": nrm((N_ODD, CONV_WIDTH, D_CONV), CONV_WIDTH ** -0.5),
        "conv_b": nrm((N_ODD, D_CONV), 0.02),
        "conv_ln_g": gain((N_ODD, D_CONV)),
        "conv_ln_b": nrm((N_ODD, D_CONV), 0.02),
        "lru_conv_w": nrm((N_ODD, LRU_CONV, D_LRU), LRU_CONV ** -0.5),
        "lru_conv_b": nrm((N_ODD, D_LRU), 0.02),
        "lru_wa": nrm((N_ODD, LRU_HEADS, LRU_HEAD, LRU_HEAD), LRU_HEAD ** -0.5),
        "lru_ba": nrm((N_ODD, D_LRU), 0.02),
        "lru_wx": nrm((N_ODD, LRU_HEADS, LRU_HEAD, LRU_HEAD), LRU_HEAD ** -0.5),
        "lru_bx": nrm((N_ODD, D_LRU), 0.02),
        "lru_lambda": lam,
        "w_out_odd": nrm((N_ODD, D_CONV + D_LRU, D_MODEL), (D_CONV + D_LRU) ** -0.5),
        "final_norm": gain((D_MODEL,)),
    }


def reference(x, meta_tokens, ffn1_norm, ffn1_wg, ffn1_wu, ffn1_wd, mix_norm, ffn2_norm, ffn2_wg, ffn2_wu,
              ffn2_wd, w_in_even, pool_w, pool_scale, hgrn_lb_logits, hgrn_gnorm, w_out_even, w_in_odd,
              conv_w, conv_b, conv_ln_g, conv_ln_b, lru_conv_w, lru_conv_b, lru_wa, lru_ba, lru_wx, lru_bx,
              lru_lambda, w_out_odd, final_norm):
    bn = x.shape[0]
    meta = jnp.broadcast_to(meta_tokens.astype(x.dtype)[None], (bn, N_META, D_MODEL))
    h = jnp.concatenate([meta, x], axis=1)
    lbs = jnp.cumsum(jax.nn.softmax(hgrn_lb_logits.astype(jnp.float32), axis=0), axis=0)
    for l in range(DEPTH):
        j = l // 2
        h = h + 0.5 * swiglu_ffn(rms_norm(h, ffn1_norm[l]), ffn1_wg[l], ffn1_wu[l], ffn1_wd[l])
        u = rms_norm(h, mix_norm[l])
        if l % 2 == 0:
            p = u @ w_in_even[j]
            p_pool, q_r, f_r, i_r, g_r = jnp.split(
                p, [D_POOL, D_POOL + D_HGRN, D_POOL + 2 * D_HGRN, D_POOL + 3 * D_HGRN], axis=-1)
            ya = multiscale_pool(p_pool, pool_w[j], pool_scale[j])
            yb = hgrn2_mixer(q_r, f_r, i_r, g_r, lbs[j], hgrn_gnorm[j])
            y = jnp.concatenate([ya, yb], axis=-1) @ w_out_even[j]
        else:
            p = u @ w_in_odd[j]
            c_a, c_b, d_x, d_g = jnp.split(p, [D_CONV, 2 * D_CONV, 2 * D_CONV + D_LRU], axis=-1)
            yc = conformer_conv_module(c_a, c_b, conv_w[j], conv_b[j], conv_ln_g[j], conv_ln_b[j])
            yd = rglru_block(d_x, d_g, lru_conv_w[j], lru_conv_b[j], lru_wa[j], lru_ba[j], lru_wx[j],
                             lru_bx[j], lru_lambda[j])
            y = jnp.concatenate([yc, yd], axis=-1) @ w_out_odd[j]
        h = h + y
        h = h + 0.5 * swiglu_ffn(rms_norm(h, ffn2_norm[l]), ffn2_wg[l], ffn2_wu[l], ffn2_wd[l])
    h = rms_norm(h, final_norm)
    return h[:, N_META:]
```

```cpp
#include <hip/hip_runtime.h>
#include <hip/hip_cooperative_groups.h>
#include <cstdio>
namespace cg = cooperative_groups;
namespace pg8 {
#define PG8_LAS __attribute__((address_space(3)))
typedef unsigned short bf16_t;
typedef short bf16x8 __attribute__((ext_vector_type(8)));
typedef float f32x4 __attribute__((ext_vector_type(4)));
typedef unsigned u32x4 __attribute__((ext_vector_type(4)));
constexpr int BM = 256, BK = 64, HALF = 128, HTB = HALF * BK * 2  , STAGE_BYTES = 8 * HTB, NXCD = 8, WGM = 8;

__host__ __device__ __forceinline__ int lds_byte(int r, int c) { const int st = (r >> 4) * 2 + (c >> 5), rr = r & 15, cc = c & 31, ob = rr * 64 + cc * 2; return st * 1024 + (ob ^ (((ob >> 9) & 1) << 5)); }
__host__ __device__ __forceinline__ void stage_rc(int b, int& R, int& C) { const int st = b / 1024, sb = b % 1024, swz = sb ^ (((sb >> 9) & 1) << 5); R = (st >> 1) * 16 + swz / 64; C = (st & 1) * 32 + (swz % 64) / 2; }
__host__ __device__ __forceinline__ int perm32(int rho) { const int n = rho >> 4, i = rho & 15; return 8 * (i >> 2) + 4 * n + (i & 3); }

struct Unit { int pm, pn; };
struct Gemm { const bf16_t* A; const bf16_t* Bt; int M, N, K; };

struct StaticOrder {
    int nM, nN, nwg, G, c;
    __host__ __device__ void init(int M, int N, int G_, int c_) { nM = M / BM; nN = N / BM; nwg = nM * nN; G = G_; c = c_; }
    __host__ __device__ bool next(int i, Unit& u) const {
        const long L = (long)i * G + c; if (L >= nwg) return false;
        int wgid = (int)L; { const int q = nwg / NXCD, r = nwg % NXCD, xcd = wgid % NXCD, off = wgid / NXCD; wgid = (xcd < r ? xcd * (q + 1) : r * (q + 1) + (xcd - r) * q) + off; }
        const int nig = WGM * nN, gid = wgid / nig, fm = gid * WGM, gsz = (nM - fm) < WGM ? (nM - fm) : WGM;
        u.pm = fm + ((wgid % nig) % gsz); u.pn = (wgid % nig) / gsz; return true;
    }
    __device__ __forceinline__ void a_ready(const Unit&) const {}
    __device__ __forceinline__ void done(const Unit&) const {}
};
template <class Epi, class Sched>
__device__ __forceinline__ void gemm_phase(PG8_LAS unsigned char* lds, const Gemm g, const Sched& S, const Epi& E) {
    const int tid = threadIdx.x, wid = __builtin_amdgcn_readfirstlane(tid >> 6), lane = tid & 63, wr = wid >> 2, wc = wid & 3, fr = lane & 15, fq = lane >> 4;
    const int K = g.K, nt = K / BK;
    unsigned voffA[2], voffB[2];
#pragma unroll
    for (int i = 0; i < 2; ++i) { int R, C; stage_rc(tid * 16 + i * 8192, R, C); const int Rb = Epi::PERM ? ((R & ~31) + perm32(R & 31)) : R;
        voffA[i] = (unsigned)(R * K + C) * 2u; voffB[i] = (unsigned)(Rb * K + C) * 2u; }
    const size_t kstep = (size_t)(BK * 2);
    const size_t hstep = (size_t)HALF * K * 2;
    const size_t tstep = 2 * hstep;
    const unsigned ldsw = (unsigned)wid * 1024u;
    const int aoff = lds_byte(wr * 64 + fr, fq * 8), boff = lds_byte(wc * 32 + fr, fq * 8);
#define PG8_SA(b, h) (((b) * 2 + (h)) * HTB)
#define PG8_SB(b, h) ((4 + (b) * 2 + (h)) * HTB)
#define PG8_STAGE(bufoff, gbase, voff) do { _Pragma("unroll") for (int _i = 0; _i < 2; ++_i) \
        __builtin_amdgcn_global_load_lds((const unsigned*)((const char*)(gbase) + (voff)[_i]), (PG8_LAS unsigned*)(lds + (bufoff) + ldsw + _i * 8192), 16, 0, 0); } while (0)
#define PG8_LDA(dst, b, h) do { _Pragma("unroll") for (int m = 0; m < 4; ++m) _Pragma("unroll") for (int k = 0; k < 2; ++k) dst[m][k] = *(const PG8_LAS bf16x8*)(lds + PG8_SA(b, h) + aoff + m * 2048 + k * 1024); } while (0)
#define PG8_LDB(dst, b, h) do { _Pragma("unroll") for (int n = 0; n < 2; ++n) _Pragma("unroll") for (int k = 0; k < 2; ++k) dst[n][k] = *(const PG8_LAS bf16x8*)(lds + PG8_SB(b, h) + boff + n * 2048 + k * 1024); } while (0)
#define PG8_MMA(ai, bj, At, Bt) do { __builtin_amdgcn_s_setprio(1); _Pragma("unroll") for (int m = 0; m < 4; ++m) _Pragma("unroll") for (int n = 0; n < 2; ++n) _Pragma("unroll") for (int k = 0; k < 2; ++k) \
        acc[ai][bj][m][n] = __builtin_amdgcn_mfma_f32_16x16x32_bf16(Bt[n][k], At[m][k], acc[ai][bj][m][n], 0, 0, 0); __builtin_amdgcn_s_setprio(0); } while (0)
#define PG8_WAIT_V(n) asm volatile("s_waitcnt vmcnt(" #n ")" ::: "memory")
#define PG8_WAIT_L(n) asm volatile("s_waitcnt lgkmcnt(" #n ")" ::: "memory")
#define PG8_BAR __builtin_amdgcn_s_barrier()
#define PG8_SCHED __builtin_amdgcn_sched_barrier(0)
    Unit cur, nxt; int ui = 0;
    if (!S.next(0, cur)) return;
    f32x4 acc[2][2][4][2];
#pragma unroll
    for (int a = 0; a < 2; ++a)
#pragma unroll
        for (int b = 0; b < 2; ++b)
#pragma unroll
            for (int m = 0; m < 4; ++m)
#pragma unroll
                for (int n = 0; n < 2; ++n) acc[a][b][m][n] = (f32x4){0.f, 0.f, 0.f, 0.f};
    bf16x8 At[4][2], B0[2][2], B1[2][2];
    const char* cA = (const char*)g.A + (size_t)cur.pm * tstep; const char* cB = (const char*)g.Bt + (size_t)cur.pn * tstep;
    S.a_ready(cur);
    PG8_STAGE(PG8_SB(0, 0), cB, voffB); PG8_STAGE(PG8_SA(0, 0), cA, voffA); PG8_STAGE(PG8_SB(0, 1), cB + hstep, voffB); PG8_STAGE(PG8_SA(0, 1), cA + hstep, voffA);
    if (wr == 1) PG8_BAR;
    PG8_WAIT_V(4); PG8_BAR;
    PG8_STAGE(PG8_SB(1, 0), cB + kstep, voffB); PG8_STAGE(PG8_SA(1, 0), cA + kstep, voffA); PG8_STAGE(PG8_SB(1, 1), cB + hstep + kstep, voffB);
    PG8_WAIT_V(6); PG8_BAR;
    for (;;) {
        const bool has_next = S.next(ui + 1, nxt);
        const char* nA = has_next ? (const char*)g.A + (size_t)nxt.pm * tstep : cA; const char* nB = has_next ? (const char*)g.Bt + (size_t)nxt.pn * tstep : cB;
        for (int t = 0; t < nt; t += 2) {
            const bool last = (t == nt - 2);
            const char* a1 = cA + (size_t)(t + 1) * kstep;
            const char* a2 = last ? nA : cA + (size_t)(t + 2) * kstep; const char* b2 = last ? nB : cB + (size_t)(t + 2) * kstep;
            const char* a3 = a2 + kstep; const char* b3 = b2 + kstep;
            if (last && has_next) S.a_ready(nxt);
            PG8_LDB(B0, 0, 0); PG8_SCHED; PG8_LDA(At, 0, 0); PG8_STAGE(PG8_SA(1, 1), a1 + hstep, voffA);
            PG8_WAIT_L(8); PG8_BAR; PG8_WAIT_L(0); PG8_MMA(0, 0, At, B0); PG8_BAR; PG8_SCHED;
            PG8_LDB(B1, 0, 1); PG8_STAGE(PG8_SB(0, 0), b2, voffB);
            PG8_BAR; PG8_WAIT_L(0); PG8_MMA(0, 1, At, B1); PG8_BAR;
            PG8_LDA(At, 0, 1); PG8_STAGE(PG8_SA(0, 0), a2, voffA);
            PG8_BAR; PG8_WAIT_L(0); PG8_MMA(1, 0, At, B0); PG8_BAR; PG8_SCHED;
            PG8_STAGE(PG8_SB(0, 1), b2 + hstep, voffB);
            PG8_WAIT_V(6); PG8_BAR; PG8_MMA(1, 1, At, B1); PG8_BAR;
            PG8_LDB(B0, 1, 0); PG8_SCHED; PG8_LDA(At, 1, 0); PG8_STAGE(PG8_SA(0, 1), a2 + hstep, voffA);
            PG8_WAIT_L(8); PG8_BAR; PG8_WAIT_L(0); PG8_MMA(0, 0, At, B0); PG8_BAR; PG8_SCHED;
            PG8_LDB(B1, 1, 1); PG8_STAGE(PG8_SB(1, 0), b3, voffB);
            PG8_BAR; PG8_WAIT_L(0); PG8_MMA(0, 1, At, B1); PG8_BAR;
            PG8_LDA(At, 1, 1); PG8_STAGE(PG8_SA(1, 0), a3, voffA);
            PG8_BAR; PG8_WAIT_L(0); PG8_MMA(1, 0, At, B0); PG8_BAR; PG8_SCHED;
            PG8_STAGE(PG8_SB(1, 1), b3 + hstep, voffB);
            PG8_WAIT_V(6); PG8_BAR; PG8_MMA(1, 1, At, B1); PG8_BAR;
        }
        if constexpr (!Epi::AFTER_DRAIN) { E(acc, cur, wr, wc, fr, fq); S.done(cur); }
        if (!has_next) break;
#pragma unroll
        for (int a = 0; a < 2; ++a)
#pragma unroll
            for (int b = 0; b < 2; ++b)
#pragma unroll
                for (int m = 0; m < 4; ++m)
#pragma unroll
                    for (int n = 0; n < 2; ++n) acc[a][b][m][n] = (f32x4){0.f, 0.f, 0.f, 0.f};
        cur = nxt; cA = nA; cB = nB; ++ui;
    }
    PG8_WAIT_V(0);
    if (wr == 0) PG8_BAR;
    PG8_BAR;
    if constexpr (Epi::AFTER_DRAIN) { E.fused(acc, cur, wr, wc, fr, fq, lds, wid, lane); S.done(cur); }
#undef PG8_SA
#undef PG8_SB
#undef PG8_STAGE
#undef PG8_LDA
#undef PG8_LDB
#undef PG8_MMA
#undef PG8_WAIT_V
#undef PG8_WAIT_L
#undef PG8_BAR
#undef PG8_SCHED
}
}

using pg8::bf16_t; using pg8::bf16x8; using pg8::f32x4; using pg8::u32x4;
typedef unsigned u32x2 __attribute__((ext_vector_type(2)));
#define LAS __attribute__((address_space(3)))
typedef LAS unsigned char* ldsp_t;

constexpr int DM = 1024, DFF = 2816, SEQ = 4096;
constexpr int MMAIN = 32768, MPAD = 33024;
constexpr int LDPE = 3328, LDPO = 2048;
constexpr int NCH = 65;
constexpr float EPS = 1e-6f;
constexpr int LDS_BYTES = 155648;

constexpr size_t SZ_UP = (size_t)5632 * 1024 * 2, SZ_DN = (size_t)1024 * 2816 * 2, SZ_INE = (size_t)3328 * 1024 * 2, SZ_SQ = (size_t)1024 * 1024 * 2, SZ_INO = (size_t)2048 * 1024 * 2;
constexpr size_t WA_UP0 = 0, WA_DN0 = WA_UP0 + SZ_UP, WA_UP1 = WA_DN0 + SZ_DN, WA_DN1 = WA_UP1 + SZ_UP, WA_INE = WA_DN1 + SZ_DN, WA_OUTE = WA_INE + SZ_INE, SZ_WA = WA_OUTE + SZ_SQ;
constexpr size_t SZ_XB = (size_t)MPAD * 1024 * 2;
constexpr size_t OFF_X1 = SZ_WA, OFF_Y = OFF_X1 + SZ_XB, OFF_BIG = OFF_Y + SZ_XB, SZ_BIG = (size_t)MPAD * 3328 * 2, OFF_R = OFF_BIG + SZ_BIG, SZ_R = (size_t)48 * 65 * 16384 * 2;
constexpr size_t OFF_HMETA = OFF_R + SZ_R, OFF_ROWSS = OFF_HMETA + (size_t)256 * 1024 * 4, OFF_DEC = OFF_ROWSS + (size_t)MPAD * 16 * 4, OFF_AAGG = OFF_DEC + (size_t)48 * 65 * 128 * 4,
                 OFF_BAGG = OFF_AAGG + (size_t)8 * 65 * 512 * 4, WS_END = OFF_BAGG + (size_t)8 * 65 * 512 * 4;
constexpr size_t WB_UP2 = 0, WB_DN2 = WB_UP2 + SZ_UP, WB_UP3 = WB_DN2 + SZ_DN, WB_DN3 = WB_UP3 + SZ_UP, WB_INO = WB_DN3 + SZ_DN, WB_OUTO = WB_INO + SZ_INO;
constexpr size_t OFF_CP = OFF_BIG + (size_t)MPAD * 2048 * 2;

struct Params { const float* in[31]; float* out; unsigned char* ws; };

__device__ __forceinline__ float bf2f(unsigned v) { return __uint_as_float(v << 16); }
__device__ __forceinline__ unsigned f2bf(float f) { unsigned u = __float_as_uint(f); u += 0x7FFFu + ((u >> 16) & 1u); return u >> 16; }
__device__ __forceinline__ unsigned pack2(float lo, float hi) { return f2bf(lo) | (f2bf(hi) << 16); }
__device__ __forceinline__ float lo16(unsigned w) { return __uint_as_float(w << 16); }
__device__ __forceinline__ float hi16(unsigned w) { return __uint_as_float(w & 0xffff0000u); }
__device__ __forceinline__ float sigm(float x) { return __builtin_amdgcn_rcpf(1.0f + __expf(-x)); }
__device__ __forceinline__ float silu(float x) { return x * sigm(x); }
__device__ __forceinline__ float gelu_tanh(float x) { const float y = 0.7978845608028654f * (x + 0.044715f * x * x * x); const float t = 1.0f - 2.0f * __builtin_amdgcn_rcpf(1.0f + __expf(2.0f * y)); return 0.5f * x * (1.0f + t); }
__device__ __forceinline__ int row_of(int b, int t) { return t < 16 ? MMAIN + t : b * SEQ + (t - 16); }

__device__ __forceinline__ float row_rstd(const float* rowss, int row, int fq) {
    const f32x4 p = *(const f32x4*)(rowss + (size_t)row * 16 + 4 * fq);
    float s = (p[0] + p[1]) + (p[2] + p[3]);
    s += __shfl_xor(s, 16); s += __shfl_xor(s, 32);
    return rsqrtf(s * (1.0f / 1024.0f) + EPS);
}

struct EpiUp {
    static constexpr bool PERM = false, AFTER_DRAIN = false;
    bf16_t* act; const float* rowss;
    __device__ __forceinline__ void operator()(const f32x4 (&acc)[2][2][4][2], const pg8::Unit& u, int wr, int wc, int fr, int fq) const {
        const int row0 = u.pm * 256 + wr * 64 + fr, j0 = u.pn * 128 + wc * 16 + 4 * fq;
#pragma unroll
        for (int ai = 0; ai < 2; ++ai)
#pragma unroll
            for (int m = 0; m < 4; ++m) {
                const int row = row0 + ai * 128 + m * 16; const float rs = row_rstd(rowss, row, fq); bf16_t* rp = act + (size_t)row * DFF + j0;
#pragma unroll
                for (int bj = 0; bj < 2; ++bj) { const f32x4 g = acc[ai][bj][m][0] * rs, uu = acc[ai][bj][m][1] * rs;
                    u32x2 w; w.x = pack2(silu(g[0]) * uu[0], silu(g[1]) * uu[1]); w.y = pack2(silu(g[2]) * uu[2], silu(g[3]) * uu[3]);
                    *(u32x2*)(rp + bj * 64) = w; }
            }
    }
};
struct EpiIn {
    static constexpr bool PERM = false, AFTER_DRAIN = false;
    bf16_t* P; int ldp; const float* rowss;
    __device__ __forceinline__ void operator()(const f32x4 (&acc)[2][2][4][2], const pg8::Unit& u, int wr, int wc, int fr, int fq) const {
        const int row0 = u.pm * 256 + wr * 64 + fr, col0 = u.pn * 256 + wc * 32 + 4 * fq;
#pragma unroll
        for (int ai = 0; ai < 2; ++ai)
#pragma unroll
            for (int m = 0; m < 4; ++m) {
                const int row = row0 + ai * 128 + m * 16; const float rs = row_rstd(rowss, row, fq); bf16_t* rp = P + (size_t)row * ldp + col0;
#pragma unroll
                for (int bj = 0; bj < 2; ++bj)
#pragma unroll
                    for (int n = 0; n < 2; ++n) { const f32x4 v = acc[ai][bj][m][n] * rs; u32x2 w; w.x = pack2(v[0], v[1]); w.y = pack2(v[2], v[3]); *(u32x2*)(rp + bj * 128 + n * 16) = w; }
            }
    }
};
struct EpiRes {
    static constexpr bool PERM = false, AFTER_DRAIN = false;
    const float* base_main; const float* base_meta; float* h_main; float* h_meta; bf16_t* hb; float* rowss; float alpha;
    __device__ __forceinline__ void operator()(const f32x4 (&acc)[2][2][4][2], const pg8::Unit& u, int wr, int wc, int fr, int fq) const {
        const float* bp = u.pm < 128 ? base_main : base_meta; float* hp = u.pm < 128 ? h_main : h_meta;
        const int row0 = u.pm * 256 + wr * 64 + fr, col0 = u.pn * 256 + wc * 32 + 4 * fq;
#pragma unroll
        for (int ai = 0; ai < 2; ++ai)
#pragma unroll
            for (int m = 0; m < 4; ++m) {
                const int row = row0 + ai * 128 + m * 16; const size_t off = (size_t)row * 1024 + col0; float ss = 0.f;
#pragma unroll
                for (int bj = 0; bj < 2; ++bj)
#pragma unroll
                    for (int n = 0; n < 2; ++n) { const size_t o = off + bj * 128 + n * 16; const f32x4 bv = *(const f32x4*)(bp + o); const f32x4 hv = bv + alpha * acc[ai][bj][m][n];
                        *(f32x4*)(hp + o) = hv; u32x2 w; w.x = pack2(hv[0], hv[1]); w.y = pack2(hv[2], hv[3]); *(u32x2*)(hb + o) = w;
                        ss += (hv[0] * hv[0] + hv[1] * hv[1]) + (hv[2] * hv[2] + hv[3] * hv[3]); }
                ss += __shfl_xor(ss, 16); ss += __shfl_xor(ss, 32);
                if (fq == 0) rowss[(size_t)row * 16 + u.pn * 4 + wc] = ss;
            }
    }
};

__device__ void convT_job(const float* __restrict__ src, int K, int N, const float* __restrict__ gain, bf16_t* __restrict__ dst, int which, ldsp_t lds) {
    LAS float* tl = (LAS float*)lds;
    const int tid = threadIdx.x; const int ntn = N >> 6, nt = (K >> 6) * ntn;
    for (int t = blockIdx.x; t < nt; t += gridDim.x) {
        const int k0 = (t / ntn) << 6, n0 = (t % ntn) << 6;
#pragma unroll
        for (int i = 0; i < 8; ++i) { const int k = (tid >> 6) + 8 * i, n = tid & 63; float v = src[(size_t)(k0 + k) * N + n0 + n]; if (gain) v *= gain[k0 + k]; tl[k * 65 + n] = v; }
        __syncthreads();
        { const int n = tid >> 3, kc = (tid & 7) * 8; const int j = n0 + n; const int drow = which < 0 ? j : ((j >> 4) * 32 + which * 16 + (j & 15));
          u32x4 w; w.x = pack2(tl[(kc + 0) * 65 + n], tl[(kc + 1) * 65 + n]); w.y = pack2(tl[(kc + 2) * 65 + n], tl[(kc + 3) * 65 + n]);
          w.z = pack2(tl[(kc + 4) * 65 + n], tl[(kc + 5) * 65 + n]); w.w = pack2(tl[(kc + 6) * 65 + n], tl[(kc + 7) * 65 + n]);
          *(u32x4*)(dst + (size_t)drow * K + k0 + kc) = w; }
        __syncthreads();
    }
}
__device__ void conv_ffn(const Params& p, int l, int second, bf16_t* up, bf16_t* dn, ldsp_t lds) {
    const float* nrm = p.in[second ? 7 : 2] + (size_t)l * DM;
    const float* wg = p.in[second ? 8 : 3] + (size_t)l * DM * DFF; const float* wu = p.in[second ? 9 : 4] + (size_t)l * DM * DFF; const float* wd = p.in[second ? 10 : 5] + (size_t)l * DFF * DM;
    convT_job(wg, DM, DFF, nrm, up, 0, lds); convT_job(wu, DM, DFF, nrm, up, 1, lds); convT_job(wd, DFF, DM, nullptr, dn, -1, lds);
}
__device__ void prep_rows(const Params& p, bf16_t* HB, float* rowss, float* hmeta) {
    const int lane = threadIdx.x & 63, gw = blockIdx.x * 8 + (threadIdx.x >> 6), nw = gridDim.x * 8;
    for (int row = gw; row < MPAD; row += nw) {
        const float* src = row < MMAIN ? p.in[0] + (size_t)row * DM : (row < MMAIN + 16 ? p.in[1] + (size_t)(row - MMAIN) * DM : nullptr);
        float ss = 0.f;
#pragma unroll
        for (int i = 0; i < 4; ++i) { const int col = i * 256 + lane * 4; f32x4 v = {0.f, 0.f, 0.f, 0.f}; if (src) v = *(const f32x4*)(src + col);
            ss += (v[0] * v[0] + v[1] * v[1]) + (v[2] * v[2] + v[3] * v[3]);
            u32x2 w; w.x = pack2(v[0], v[1]); w.y = pack2(v[2], v[3]); *(u32x2*)(HB + (size_t)row * DM + col) = w;
            if (row >= MMAIN) *(f32x4*)(hmeta + (size_t)(row - MMAIN) * DM + col) = v; }
#pragma unroll
        for (int o = 32; o >= 1; o >>= 1) ss += __shfl_xor(ss, o);
        if (lane < 16) rowss[(size_t)row * 16 + lane] = lane == 0 ? ss : 0.f;
    }
}

__device__ __forceinline__ f32x4 mfma16(bf16x8 a, bf16x8 b, f32x4 c) { return __builtin_amdgcn_mfma_f32_16x16x32_bf16(a, b, c, 0, 0, 0); }

__device__ void hg_phaseA(const Params& p, const bf16_t* P, bf16_t* states, float* dec, ldsp_t lds) {
    LAS float* Lb = (LAS float*)lds;
    LAS bf16_t* Z = (LAS bf16_t*)(lds + 32768);
    LAS bf16_t* VT = (LAS bf16_t*)(lds + 49152);
    LAS bf16_t* KlT = (LAS bf16_t*)(lds + 49152 + 18432);
    LAS float* Tot = (LAS float*)(lds + 49152 + 36864);
    const int tid = threadIdx.x, lane = tid & 63, w = tid >> 6, fr = lane & 15, fq = lane >> 4;
    const float* lbl = p.in[14];
    for (int it = blockIdx.x; it < 48 * 64; it += gridDim.x) {
        const int c = it & 63, bh = it >> 6, b = bh / 6, h = bh % 6;
#pragma unroll
        for (int i = 0; i < 2; ++i) {
            const int idx = tid + 512 * i, s = idx >> 4, c8 = (idx & 15) * 8; const bool valid = c > 0 || s < 16;
            const int row = c == 0 ? MMAIN + s : b * SEQ + 64 * (c - 1) + s;
            u32x4 zf = {0u, 0u, 0u, 0u}, vv = {0u, 0u, 0u, 0u};
            if (valid) { zf = *(const u32x4*)(P + (size_t)row * LDPE + 1024 + 128 * h + c8); vv = *(const u32x4*)(P + (size_t)row * LDPE + 1792 + 128 * h + c8); }
            *(LAS u32x4*)(Z + s * 128 + c8) = zf;
#pragma unroll
            for (int e = 0; e < 4; ++e) { VT[(c8 + 2 * e) * 72 + s] = (bf16_t)(vv[e] & 0xffffu); VT[(c8 + 2 * e + 1) * 72 + s] = (bf16_t)(vv[e] >> 16); }
        }
        __syncthreads();
        const int ch = tid & 127, sb = tid >> 7;
        const float lb = sigm(lbl[128 * h + ch] - lbl[768 + 128 * h + ch]);
        {
            float run = 0.f;
#pragma unroll
            for (int q = 0; q < 16; ++q) { const int s = 16 * sb + q; const bool valid = c > 0 || s < 16; const float z = bf2f(Z[s * 128 + ch]);
                const float f = lb + (1.0f - lb) * sigm(z); run += valid ? __logf(f) : 0.f; Lb[s * 128 + ch] = run; }
            Tot[sb * 128 + ch] = run;
        }
        __syncthreads();
        {
            const float t0 = Tot[ch], t1 = Tot[128 + ch], t2 = Tot[256 + ch], t3 = Tot[384 + ch];
            const float rsb = sb == 0 ? 0.f : (sb == 1 ? t0 : (sb == 2 ? t0 + t1 : t0 + t1 + t2)); const float blast = (t0 + t1) + (t2 + t3);
            unsigned pk[8];
#pragma unroll
            for (int q = 0; q < 16; q += 2) {
                float kl[2];
#pragma unroll
                for (int e = 0; e < 2; ++e) { const int s = 16 * sb + q + e; const bool valid = c > 0 || s < 16; const float z = bf2f(Z[s * 128 + ch]);
                    const float kk = valid ? (1.0f - lb) * sigm(-z) : 0.f; const float bs = rsb + Lb[s * 128 + ch]; kl[e] = kk * __expf(blast - bs); }
                pk[q >> 1] = pack2(kl[0], kl[1]);
            }
            u32x4 w0 = {pk[0], pk[1], pk[2], pk[3]}, w1 = {pk[4], pk[5], pk[6], pk[7]};
            *(LAS u32x4*)(KlT + ch * 72 + 16 * sb) = w0; *(LAS u32x4*)(KlT + ch * 72 + 16 * sb + 8) = w1;
            if (sb == 0) dec[((size_t)bh * NCH + c) * 128 + ch] = __expf(blast);
        }
        __syncthreads();
        {
            f32x4 acc[8];
#pragma unroll
            for (int vb = 0; vb < 8; ++vb) acc[vb] = (f32x4){0.f, 0.f, 0.f, 0.f};
#pragma unroll
            for (int kk = 0; kk < 2; ++kk) {
                const bf16x8 a = *(const LAS bf16x8*)(KlT + (16 * w + fr) * 72 + 32 * kk + 8 * fq);
#pragma unroll
                for (int vb = 0; vb < 8; ++vb) { const bf16x8 bb = *(const LAS bf16x8*)(VT + (16 * vb + fr) * 72 + 32 * kk + 8 * fq); acc[vb] = mfma16(a, bb, acc[vb]); }
            }
            bf16_t* st = states + ((size_t)bh * NCH + c) * 16384;
#pragma unroll
            for (int vb = 0; vb < 8; ++vb) { u32x2 o; o.x = pack2(acc[vb][0], acc[vb][1]); o.y = pack2(acc[vb][2], acc[vb][3]); *(u32x2*)(st + (16 * vb + fr) * 128 + 16 * w + 4 * fq) = o; }
        }
        __syncthreads();
    }
}

__device__ void hg_phaseB(bf16_t* states, const float* dec) {
    const int idx = blockIdx.x * 512 + threadIdx.x;
    if (idx >= 48 * 2048) return;
    const int bh = idx >> 11, e8 = idx & 2047, k0 = (e8 & 15) * 8;
    bf16_t* sp = states + (size_t)bh * NCH * 16384 + (size_t)e8 * 8; const float* dp = dec + (size_t)bh * NCH * 128 + k0;
    float S[8];
#pragma unroll
    for (int e = 0; e < 8; ++e) S[e] = 0.f;
    for (int c0 = 0; c0 < 64; c0 += 8) {
        u32x4 u[8]; f32x4 d0[8], d1[8];
#pragma unroll
        for (int j = 0; j < 8; ++j) { u[j] = *(const u32x4*)(sp + (size_t)(c0 + j) * 16384); d0[j] = *(const f32x4*)(dp + (c0 + j) * 128); d1[j] = *(const f32x4*)(dp + (c0 + j) * 128 + 4); }
#pragma unroll
        for (int j = 0; j < 8; ++j) {
            u32x4 o; o.x = pack2(S[0], S[1]); o.y = pack2(S[2], S[3]); o.z = pack2(S[4], S[5]); o.w = pack2(S[6], S[7]);
            *(u32x4*)(sp + (size_t)(c0 + j) * 16384) = o;
            S[0] = d0[j][0] * S[0] + lo16(u[j].x); S[1] = d0[j][1] * S[1] + hi16(u[j].x); S[2] = d0[j][2] * S[2] + lo16(u[j].y); S[3] = d0[j][3] * S[3] + hi16(u[j].y);
            S[4] = d1[j][0] * S[4] + lo16(u[j].z); S[5] = d1[j][1] * S[5] + hi16(u[j].z); S[6] = d1[j][2] * S[6] + lo16(u[j].w); S[7] = d1[j][3] * S[7] + hi16(u[j].w);
        }
    }
    u32x4 o; o.x = pack2(S[0], S[1]); o.y = pack2(S[2], S[3]); o.z = pack2(S[4], S[5]); o.w = pack2(S[6], S[7]);
    *(u32x4*)(sp + (size_t)64 * 16384) = o;
}

__device__ void hg_phaseC(const Params& p, const bf16_t* P, const bf16_t* states, bf16_t* Y, ldsp_t lds) {
    LAS float* Lb = (LAS float*)lds;
    LAS bf16_t* Z = (LAS bf16_t*)(lds + 32768);
    LAS bf16_t* Qb = (LAS bf16_t*)(lds + 49152);
    LAS bf16_t* Qd = (LAS bf16_t*)(lds + 66560);
    LAS bf16_t* Kd = (LAS bf16_t*)(lds + 83968);
    LAS bf16_t* VT = (LAS bf16_t*)(lds + 127488);
    LAS bf16_t* Am = (LAS bf16_t*)(lds + 145920);
    LAS float* Tot = (LAS float*)(lds + 145920);
    LAS float* O = (LAS float*)lds;
    const int tid = threadIdx.x, lane = tid & 63, w = tid >> 6, fr = lane & 15, fq = lane >> 4;
    const float* lbl = p.in[14]; const float* gnorm = p.in[15];
    for (int it = blockIdx.x; it < 48 * NCH; it += gridDim.x) {
        const int c = it % NCH, bh = it / NCH, b = bh / 6, h = bh % 6;
        if (c == 0 && b != 0) continue;
#pragma unroll
        for (int i = 0; i < 2; ++i) {
            const int idx = tid + 512 * i, s = idx >> 4, c8 = (idx & 15) * 8; const bool valid = c > 0 || s < 16;
            const int row = c == 0 ? MMAIN + s : b * SEQ + 64 * (c - 1) + s;
            u32x4 zf = {0u, 0u, 0u, 0u}, vv = {0u, 0u, 0u, 0u}, qq = {0u, 0u, 0u, 0u};
            if (valid) { const bf16_t* pr = P + (size_t)row * LDPE + 128 * h + c8; qq = *(const u32x4*)(pr + 256); zf = *(const u32x4*)(pr + 1024); vv = *(const u32x4*)(pr + 1792); }
            *(LAS u32x4*)(Z + s * 128 + c8) = zf; *(LAS u32x4*)(Qd + s * 136 + c8) = qq;
#pragma unroll
            for (int e = 0; e < 4; ++e) { VT[(c8 + 2 * e) * 72 + s] = (bf16_t)(vv[e] & 0xffffu); VT[(c8 + 2 * e + 1) * 72 + s] = (bf16_t)(vv[e] >> 16); }
        }
        __syncthreads();
        const int ch = tid & 127, sb = tid >> 7;
        const float lb = sigm(lbl[128 * h + ch] - lbl[768 + 128 * h + ch]);
        {
            float run = 0.f;
#pragma unroll
            for (int q = 0; q < 16; ++q) { const int s = 16 * sb + q; const bool valid = c > 0 || s < 16; const float z = bf2f(Z[s * 128 + ch]);
                const float f = lb + (1.0f - lb) * sigm(z); run += valid ? __logf(f) : 0.f; Lb[s * 128 + ch] = run; }
            Tot[sb * 128 + ch] = run;
        }
        __syncthreads();
        {
            const float t0 = Tot[ch], t1 = Tot[128 + ch], t2 = Tot[256 + ch];
            const float r1 = t0, r2 = t0 + t1, r3 = r2 + t2;
            const float rsb = sb == 0 ? 0.f : (sb == 1 ? r1 : (sb == 2 ? r2 : r3));
            const float dr0 = 0.f - rsb, dr1 = r1 - rsb, dr2 = r2 - rsb, dr3 = r3 - rsb;
#pragma unroll
            for (int q = 0; q < 16; ++q) {
                const int s = 16 * sb + q; const bool valid = c > 0 || s < 16; const float z = bf2f(Z[s * 128 + ch]);
                const float kk = valid ? (1.0f - lb) * sigm(-z) : 0.f; const float bloc = Lb[s * 128 + ch];
                const float qv = valid ? silu(bf2f(Qd[s * 136 + ch])) : 0.f;
                Qd[s * 136 + ch] = (bf16_t)f2bf(qv * __expf(bloc)); Qb[s * 136 + ch] = (bf16_t)f2bf(qv * __expf(bloc + rsb));
                if (sb <= 0) Kd[(0 + s) * 136 + ch] = (bf16_t)f2bf(kk * __expf(dr0 - bloc));
                if (sb <= 1) Kd[(16 + s) * 136 + ch] = (bf16_t)f2bf(kk * __expf(dr1 - bloc));
                if (sb <= 2) Kd[(48 + s) * 136 + ch] = (bf16_t)f2bf(kk * __expf(dr2 - bloc));
                Kd[(96 + s) * 136 + ch] = (bf16_t)f2bf(kk * __expf(dr3 - bloc));
            }
        }
        __syncthreads();
        for (int bi = w; bi < 10; bi += 8) {
            const int i = bi >= 6 ? 3 : (bi >= 3 ? 2 : (bi >= 1 ? 1 : 0)); const int j = bi - (i * (i + 1)) / 2; const int offi = i == 0 ? 0 : (i == 1 ? 16 : (i == 2 ? 48 : 96));
            f32x4 acc = {0.f, 0.f, 0.f, 0.f};
#pragma unroll
            for (int kk = 0; kk < 4; ++kk) { const bf16x8 a = *(const LAS bf16x8*)(Qd + (16 * i + fr) * 136 + 32 * kk + 8 * fq); const bf16x8 bb = *(const LAS bf16x8*)(Kd + (offi + 16 * j + fr) * 136 + 32 * kk + 8 * fq); acc = mfma16(a, bb, acc); }
#pragma unroll
            for (int e = 0; e < 4; ++e) { const float v = (j == i && fr > 4 * fq + e) ? 0.f : acc[e]; Am[(16 * i + 4 * fq + e) * 72 + 16 * j + fr] = (bf16_t)f2bf(v); }
        }
        if (w >= 2) { const int zb = w - 2; const int zi = zb < 3 ? 0 : (zb < 5 ? 1 : 2); const int zj = zb < 3 ? zb + 1 : (zb < 5 ? zb - 1 : 3);
#pragma unroll
            for (int e = 0; e < 4; ++e) Am[(16 * zi + 4 * fq + e) * 72 + 16 * zj + fr] = (bf16_t)0; }
        __syncthreads();
        {
            const int tb = w >> 1, vb0 = 4 * (w & 1);
            f32x4 acc[4];
#pragma unroll
            for (int vi = 0; vi < 4; ++vi) acc[vi] = (f32x4){0.f, 0.f, 0.f, 0.f};
            const bf16_t* st = states + ((size_t)bh * NCH + c) * 16384;
#pragma unroll
            for (int kk = 0; kk < 4; ++kk) { const bf16x8 a = *(const LAS bf16x8*)(Qb + (16 * tb + fr) * 136 + 32 * kk + 8 * fq);
#pragma unroll
                for (int vi = 0; vi < 4; ++vi) { const bf16x8 bb = *(const bf16x8*)(st + (16 * (vb0 + vi) + fr) * 128 + 32 * kk + 8 * fq); acc[vi] = mfma16(a, bb, acc[vi]); } }
#pragma unroll
            for (int kk = 0; kk < 2; ++kk) { const bf16x8 a = *(const LAS bf16x8*)(Am + (16 * tb + fr) * 72 + 32 * kk + 8 * fq);
#pragma unroll
                for (int vi = 0; vi < 4; ++vi) { const bf16x8 bb = *(const LAS bf16x8*)(VT + (16 * (vb0 + vi) + fr) * 72 + 32 * kk + 8 * fq); acc[vi] = mfma16(a, bb, acc[vi]); } }
#pragma unroll
            for (int vi = 0; vi < 4; ++vi)
#pragma unroll
                for (int e = 0; e < 4; ++e) O[(16 * tb + 4 * fq + e) * 132 + 16 * (vb0 + vi) + fr] = acc[vi][e];
        }
        __syncthreads();
        {
            const int t = tid >> 3, v0 = (tid & 7) * 16; const bool valid = c > 0 || t < 16; const int row = c == 0 ? MMAIN + t : b * SEQ + 64 * (c - 1) + t;
            f32x4 o[4]; float ss = 0.f;
#pragma unroll
            for (int i = 0; i < 4; ++i) { o[i] = *(const LAS f32x4*)(O + t * 132 + v0 + 4 * i); ss += (o[i][0] * o[i][0] + o[i][1] * o[i][1]) + (o[i][2] * o[i][2] + o[i][3] * o[i][3]); }
            ss += __shfl_xor(ss, 1); ss += __shfl_xor(ss, 2); ss += __shfl_xor(ss, 4);
            const float rn = rsqrtf(ss * (1.0f / 128.0f) + EPS);
            if (valid) {
                const bf16_t* gp = P + (size_t)row * LDPE + 2560 + 128 * h + v0; const u32x4 g0 = *(const u32x4*)gp, g1 = *(const u32x4*)(gp + 8);
                const unsigned gw[8] = {g0.x, g0.y, g0.z, g0.w, g1.x, g1.y, g1.z, g1.w}; unsigned ow[8];
#pragma unroll
                for (int i = 0; i < 4; ++i) { const f32x4 gn = *(const f32x4*)(gnorm + v0 + 4 * i);
                    const float y0 = o[i][0] * rn * gn[0] * silu(lo16(gw[2 * i])), y1 = o[i][1] * rn * gn[1] * silu(hi16(gw[2 * i])), y2 = o[i][2] * rn * gn[2] * silu(lo16(gw[2 * i + 1])), y3 = o[i][3] * rn * gn[3] * silu(hi16(gw[2 * i + 1]));
                    ow[2 * i] = pack2(y0, y1); ow[2 * i + 1] = pack2(y2, y3); }
                bf16_t* yp = Y + (size_t)row * DM + 256 + 128 * h + v0;
                *(u32x4*)yp = (u32x4){ow[0], ow[1], ow[2], ow[3]}; *(u32x4*)(yp + 8) = (u32x4){ow[4], ow[5], ow[6], ow[7]};
            }
        }
        __syncthreads();
    }
}

__device__ void pool_items(const Params& p, const bf16_t* P, bf16_t* Y, ldsp_t lds) {
    LAS float* U = (LAS float*)lds;
    LAS float* Wp = (LAS float*)(lds + 20224);
    LAS float* Mx = (LAS float*)(lds + 36608);
    const int tid = threadIdx.x; const float* pw = p.in[12]; const float* pscale = p.in[13];
    for (int it = blockIdx.x; it < 513 * 4; it += gridDim.x) {
        const int g = it & 3, bc = it >> 2; const int b = bc == 512 ? 0 : bc >> 6, c = bc == 512 ? 0 : (bc & 63) + 1;
        const int t0 = c == 0 ? 0 : 16 + 64 * (c - 1), ntok = c == 0 ? 16 : 64, wsz = 2 << g;
        for (int idx = tid; idx < 79 * 8; idx += 512) { const int r = idx >> 3, c8 = (idx & 7) * 8, ta = t0 - 15 + r; u32x4 v = {0u, 0u, 0u, 0u};
            if (ta >= 0 && r < 15 + ntok) v = *(const u32x4*)(P + (size_t)row_of(b, ta) * LDPE + 64 * g + c8);
            LAS float* up = U + r * 64 + c8; up[0] = lo16(v.x); up[1] = hi16(v.x); up[2] = lo16(v.y); up[3] = hi16(v.y); up[4] = lo16(v.z); up[5] = hi16(v.z); up[6] = lo16(v.w); up[7] = hi16(v.w); }
#pragma unroll
        for (int i = 0; i < 8; ++i) Wp[tid + 512 * i] = pw[g * 4096 + tid + 512 * i];
        __syncthreads();
#pragma unroll
        for (int i = 0; i < 8; ++i) { const int idx = tid + 512 * i, s = idx >> 6, ch = idx & 63, ta = t0 + s; float sum = 0.f;
            for (int j = 0; j < wsz; ++j) sum += U[(s + 15 - j) * 64 + ch];
            const int cnt = (ta + 1) < wsz ? (ta + 1) : wsz; Mx[s * 65 + ch] = sum / (float)cnt - U[(s + 15) * 64 + ch]; }
        __syncthreads();
        { const int s = tid >> 3, d0 = (tid & 7) * 8; f32x4 a0 = {0.f, 0.f, 0.f, 0.f}, a1 = {0.f, 0.f, 0.f, 0.f};
          for (int ch = 0; ch < 64; ++ch) { const float m = Mx[s * 65 + ch]; a0 += m * *(const LAS f32x4*)(Wp + ch * 64 + d0); a1 += m * *(const LAS f32x4*)(Wp + ch * 64 + d0 + 4); }
          if (s < ntok) { const f32x4 s0 = *(const f32x4*)(pscale + 64 * g + d0), s1 = *(const f32x4*)(pscale + 64 * g + d0 + 4); a0 *= s0; a1 *= s1;
              u32x4 o; o.x = pack2(a0[0], a0[1]); o.y = pack2(a0[2], a0[3]); o.z = pack2(a1[0], a1[1]); o.w = pack2(a1[2], a1[3]);
              *(u32x4*)(Y + (size_t)row_of(b, t0 + s) * DM + 64 * g + d0) = o; } }
        __syncthreads();
    }
}

__device__ void conv_items(const Params& p, const bf16_t* P, bf16_t* Y, ldsp_t lds) {
    LAS float* U = (LAS float*)lds;
    LAS float* Wc = (LAS float*)(lds + 48128);
    LAS float* Cv = (LAS float*)(lds + 64000);
    const int tid = threadIdx.x; const float* cw = p.in[18]; const float* cb = p.in[19]; const float* lg = p.in[20]; const float* lbb = p.in[21];
    for (int it = blockIdx.x; it < 513 * 4; it += gridDim.x) {
        const int g = it & 3, bc = it >> 2; const int b = bc == 512 ? 0 : bc >> 6, c = bc == 512 ? 0 : (bc & 63) + 1;
        const int t0 = c == 0 ? 0 : 16 + 64 * (c - 1), ntok = c == 0 ? 16 : 64;
        for (int idx = tid; idx < 94 * 16; idx += 512) { const int r = idx >> 4, c8 = (idx & 15) * 8, ta = t0 - 30 + r; u32x4 av = {0u, 0u, 0u, 0u}, bv = {0u, 0u, 0u, 0u};
            if (ta >= 0 && r < 30 + ntok) { const bf16_t* pr = P + (size_t)row_of(b, ta) * LDPO + 128 * g + c8; av = *(const u32x4*)pr; bv = *(const u32x4*)(pr + 512); }
            LAS float* up = U + r * 128 + c8;
            up[0] = lo16(av.x) * sigm(lo16(bv.x)); up[1] = hi16(av.x) * sigm(hi16(bv.x)); up[2] = lo16(av.y) * sigm(lo16(bv.y)); up[3] = hi16(av.y) * sigm(hi16(bv.y));
            up[4] = lo16(av.z) * sigm(lo16(bv.z)); up[5] = hi16(av.z) * sigm(hi16(bv.z)); up[6] = lo16(av.w) * sigm(lo16(bv.w)); up[7] = hi16(av.w) * sigm(hi16(bv.w)); }
        for (int idx = tid; idx < 31 * 128; idx += 512) Wc[idx] = cw[(idx >> 7) * 512 + 128 * g + (idx & 127)];
        __syncthreads();
        { const int ch = tid & 127, sb = tid >> 7; const float bias = cb[128 * g + ch];
          for (int q = 0; q < 16; ++q) { const int s = 16 * sb + q; float acc = bias;
#pragma unroll
              for (int j = 0; j < 31; ++j) acc += Wc[j * 128 + ch] * U[(s + j) * 128 + ch];
              Cv[s * 128 + ch] = acc; } }
        __syncthreads();
        { const int t = tid >> 3, c0 = (tid & 7) * 16; f32x4 v[4]; float sm = 0.f;
#pragma unroll
          for (int i = 0; i < 4; ++i) { v[i] = *(const LAS f32x4*)(Cv + t * 128 + c0 + 4 * i); sm += (v[i][0] + v[i][1]) + (v[i][2] + v[i][3]); }
          sm += __shfl_xor(sm, 1); sm += __shfl_xor(sm, 2); sm += __shfl_xor(sm, 4);
          const float mu = sm * (1.0f / 128.0f); float sq = 0.f;
#pragma unroll
          for (int i = 0; i < 4; ++i) { v[i] -= mu; sq += (v[i][0] * v[i][0] + v[i][1] * v[i][1]) + (v[i][2] * v[i][2] + v[i][3] * v[i][3]); }
          sq += __shfl_xor(sq, 1); sq += __shfl_xor(sq, 2); sq += __shfl_xor(sq, 4);
          const float rs = rsqrtf(sq * (1.0f / 128.0f) + EPS);
          if (t < ntok) { unsigned ow[8];
#pragma unroll
              for (int i = 0; i < 4; ++i) { const f32x4 gg = *(const f32x4*)(lg + 128 * g + c0 + 4 * i), bb = *(const f32x4*)(lbb + 128 * g + c0 + 4 * i); const f32x4 un = v[i] * rs * gg + bb;
                  ow[2 * i] = pack2(silu(un[0]), silu(un[1])); ow[2 * i + 1] = pack2(silu(un[2]), silu(un[3])); }
              bf16_t* yp = Y + (size_t)row_of(b, t0 + t) * DM + 128 * g + c0;
              *(u32x4*)yp = (u32x4){ow[0], ow[1], ow[2], ow[3]}; *(u32x4*)(yp + 8) = (u32x4){ow[4], ow[5], ow[6], ow[7]}; } }
        __syncthreads();
    }
}

__device__ void lru_items(const Params& p, const bf16_t* P, float* hloc, float* cpo, float* aagg, float* bagg, ldsp_t lds) {
    LAS float* XB = (LAS float*)lds;
    LAS float* Uc = (LAS float*)(lds + 17152);
    LAS float* Wa = (LAS float*)(lds + 33536);
    LAS float* Wx = (LAS float*)(lds + 49920);
    LAS float* Aa = (LAS float*)(lds + 66304);
    LAS float* Bt = (LAS float*)(lds + 82688);
    LAS float* Ag = (LAS float*)(lds + 99072);
    LAS float* Bg = (LAS float*)(lds + 101120);
    const int tid = threadIdx.x;
    const float* cw = p.in[22]; const float* cb = p.in[23]; const float* wa = p.in[24]; const float* ba = p.in[25]; const float* wx = p.in[26]; const float* bx = p.in[27]; const float* lam = p.in[28];
    for (int it = blockIdx.x; it < 8 * NCH * 8; it += gridDim.x) {
        const int hh = it & 7, bc = it >> 3, b = bc / NCH, c = bc % NCH;
        const int t0 = c == 0 ? 0 : 16 + 64 * (c - 1), ntok = c == 0 ? 16 : 64;
        for (int idx = tid; idx < 67 * 8; idx += 512) { const int r = idx >> 3, c8 = (idx & 7) * 8, ta = t0 - 3 + r; u32x4 v = {0u, 0u, 0u, 0u};
            if (ta >= 0 && r < 3 + ntok) v = *(const u32x4*)(P + (size_t)row_of(b, ta) * LDPO + 1024 + 64 * hh + c8);
            LAS float* up = XB + r * 64 + c8; up[0] = lo16(v.x); up[1] = hi16(v.x); up[2] = lo16(v.y); up[3] = hi16(v.y); up[4] = lo16(v.z); up[5] = hi16(v.z); up[6] = lo16(v.w); up[7] = hi16(v.w); }
#pragma unroll
        for (int i = 0; i < 8; ++i) { Wa[tid + 512 * i] = wa[hh * 4096 + tid + 512 * i]; Wx[tid + 512 * i] = wx[hh * 4096 + tid + 512 * i]; }
        __syncthreads();
#pragma unroll
        for (int i = 0; i < 8; ++i) { const int idx = tid + 512 * i, s = idx >> 6, ch = idx & 63; float u = cb[64 * hh + ch];
#pragma unroll
            for (int j = 0; j < 4; ++j) u += cw[j * 512 + 64 * hh + ch] * XB[(s + j) * 64 + ch];
            Uc[idx] = u; }
        __syncthreads();
        { const int s = tid >> 3, o0 = (tid & 7) * 8; f32x4 ra0 = *(const f32x4*)(ba + 64 * hh + o0), ra1 = *(const f32x4*)(ba + 64 * hh + o0 + 4), ia0 = *(const f32x4*)(bx + 64 * hh + o0), ia1 = *(const f32x4*)(bx + 64 * hh + o0 + 4);
          for (int i = 0; i < 64; ++i) { const float u = Uc[s * 64 + i];
              ra0 += u * *(const LAS f32x4*)(Wa + i * 64 + o0); ra1 += u * *(const LAS f32x4*)(Wa + i * 64 + o0 + 4); ia0 += u * *(const LAS f32x4*)(Wx + i * 64 + o0); ia1 += u * *(const LAS f32x4*)(Wx + i * 64 + o0 + 4); }
          const bool valid = s < ntok; const bool first = (t0 + s) == 0;
#pragma unroll
          for (int e = 0; e < 8; ++e) { const float rr = sigm(e < 4 ? ra0[e & 3] : ra1[e & 3]), ig = sigm(e < 4 ? ia0[e & 3] : ia1[e & 3]); const int o = o0 + e;
              const float sp = log1pf(__expf(-lam[64 * hh + o])); const float la = -8.0f * rr * sp; const float a = __expf(la); const float mult = sqrtf(-expm1f(2.0f * la));
              const float bt = (first ? 1.0f : mult) * ig * Uc[s * 64 + o];
              Aa[s * 64 + o] = valid ? a : 1.0f; Bt[s * 64 + o] = valid ? bt : 0.f; } }
        __syncthreads();
        const int ch = tid & 63, sb = tid >> 6;
        { float cp = 1.0f, hv = 0.f;
#pragma unroll
          for (int q = 0; q < 8; ++q) { const int s = 8 * sb + q; const float a = Aa[s * 64 + ch], bt = Bt[s * 64 + ch]; hv = a * hv + bt; cp *= a; Aa[s * 64 + ch] = cp; Bt[s * 64 + ch] = hv; }
          Ag[sb * 64 + ch] = cp; Bg[sb * 64 + ch] = hv; }
        __syncthreads();
        { float carry = 0.f, cpin = 1.0f;
          for (int q = 0; q < sb; ++q) { const float a = Ag[q * 64 + ch]; carry = a * carry + Bg[q * 64 + ch]; cpin *= a; }
          float hl = 0.f, cf = 1.0f;
#pragma unroll
          for (int q = 0; q < 8; ++q) { const int s = 8 * sb + q; hl = Bt[s * 64 + ch] + Aa[s * 64 + ch] * carry; cf = Aa[s * 64 + ch] * cpin;
              if (s < ntok && (c > 0 || b == 0)) { const size_t o = (size_t)row_of(b, t0 + s) * 512 + 64 * hh + ch; hloc[o] = hl; cpo[o] = cf; } }
          if (sb == 7) { aagg[((size_t)b * NCH + c) * 512 + 64 * hh + ch] = cf; bagg[((size_t)b * NCH + c) * 512 + 64 * hh + ch] = hl; } }
        __syncthreads();
    }
}

__device__ void lru_combine(const bf16_t* P, const float* hloc, const float* cpo, const float* aagg, const float* bagg, bf16_t* Y) {
    const int ch = threadIdx.x;
    for (int bc = blockIdx.x; bc < 513; bc += gridDim.x) {
        const int b = bc == 512 ? 0 : bc >> 6, c = bc == 512 ? 0 : (bc & 63) + 1;
        const int t0 = c == 0 ? 0 : 16 + 64 * (c - 1), ntok = c == 0 ? 16 : 64;
        float carry = 0.f;
        for (int q = 0; q < c; ++q) { const size_t o = ((size_t)b * NCH + q) * 512 + ch; carry = aagg[o] * carry + bagg[o]; }
        for (int s = 0; s < ntok; ++s) { const size_t row = (size_t)row_of(b, t0 + s); const float hv = hloc[row * 512 + ch] + cpo[row * 512 + ch] * carry;
            const float gt = bf2f(P[row * LDPO + 1536 + ch]); Y[row * DM + 512 + ch] = (bf16_t)f2bf(gelu_tanh(gt) * hv); }
    }
}

__device__ void final_norm(float* H, const float* fn) {
    const int lane = threadIdx.x & 63, gw = blockIdx.x * 8 + (threadIdx.x >> 6), nw = gridDim.x * 8;
    for (int row = gw; row < MMAIN; row += nw) {
        float* hp = H + (size_t)row * DM; f32x4 v[4]; float ss = 0.f;
#pragma unroll
        for (int i = 0; i < 4; ++i) { v[i] = *(const f32x4*)(hp + i * 256 + lane * 4); ss += (v[i][0] * v[i][0] + v[i][1] * v[i][1]) + (v[i][2] * v[i][2] + v[i][3] * v[i][3]); }
#pragma unroll
        for (int o = 32; o >= 1; o >>= 1) ss += __shfl_xor(ss, o);
        const float rs = rsqrtf(ss * (1.0f / 1024.0f) + EPS);
#pragma unroll
        for (int i = 0; i < 4; ++i) { const f32x4 g = *(const f32x4*)(fn + i * 256 + lane * 4); *(f32x4*)(hp + i * 256 + lane * 4) = v[i] * rs * g; }
    }
}

template <class Epi> __device__ __forceinline__ void run_gemm(ldsp_t lds, const bf16_t* A, const bf16_t* Bt, int N, int K, const Epi& E) {
    pg8::Gemm g{A, Bt, MPAD, N, K}; pg8::StaticOrder S; S.init(MPAD, N, (int)gridDim.x, (int)blockIdx.x);
    pg8::gemm_phase<Epi, pg8::StaticOrder>(lds, g, S, E);
}

__global__ void __launch_bounds__(512, 2) fwd_megakernel(Params p) {
    extern __shared__ __attribute__((aligned(16))) unsigned char lds_raw[];
    cg::grid_group grid = cg::this_grid();
    ldsp_t lds = (ldsp_t)lds_raw;
    unsigned char* ws = p.ws;
    bf16_t* X1 = (bf16_t*)(ws + OFF_X1); bf16_t* Y = (bf16_t*)(ws + OFF_Y); bf16_t* BIG = (bf16_t*)(ws + OFF_BIG); unsigned char* R = ws + OFF_R;
    float* hmeta = (float*)(ws + OFF_HMETA); float* rowss = (float*)(ws + OFF_ROWSS); float* dec = (float*)(ws + OFF_DEC); float* aagg = (float*)(ws + OFF_AAGG); float* bagg = (float*)(ws + OFF_BAGG);
    float* hmeta_off = hmeta - (size_t)MMAIN * DM;
#define GEMM_UP(WOFF) { EpiUp eu{BIG, rowss}; run_gemm<EpiUp>(lds, X1, (const bf16_t*)(WOFF), 5632, DM, eu); } grid.sync();
#define GEMM_DOWN(WOFF, BASEMAIN) { EpiRes er{BASEMAIN, hmeta_off, p.out, hmeta_off, X1, rowss, 0.5f}; run_gemm<EpiRes>(lds, BIG, (const bf16_t*)(WOFF), DM, DFF, er); } grid.sync();
#define GEMM_OUT(WOFF) { EpiRes er{p.out, hmeta_off, p.out, hmeta_off, X1, rowss, 1.0f}; run_gemm<EpiRes>(lds, Y, (const bf16_t*)(WOFF), DM, DM, er); } grid.sync();
    conv_ffn(p, 0, 0, (bf16_t*)(ws + WA_UP0), (bf16_t*)(ws + WA_DN0), lds); conv_ffn(p, 0, 1, (bf16_t*)(ws + WA_UP1), (bf16_t*)(ws + WA_DN1), lds);
    convT_job(p.in[11], DM, 3328, p.in[6], (bf16_t*)(ws + WA_INE), -1, lds); convT_job(p.in[16], DM, DM, nullptr, (bf16_t*)(ws + WA_OUTE), -1, lds);
    prep_rows(p, X1, rowss, hmeta);
    grid.sync();
    GEMM_UP(ws + WA_UP0) GEMM_DOWN(ws + WA_DN0, p.in[0])
    { EpiIn ei{BIG, LDPE, rowss}; run_gemm<EpiIn>(lds, X1, (const bf16_t*)(ws + WA_INE), 3328, DM, ei); } grid.sync();
    hg_phaseA(p, BIG, (bf16_t*)R, dec, lds); pool_items(p, BIG, Y, lds); grid.sync();
    hg_phaseB((bf16_t*)R, dec); grid.sync();
    hg_phaseC(p, BIG, (const bf16_t*)R, Y, lds); grid.sync();
    conv_ffn(p, 1, 0, (bf16_t*)(R + WB_UP2), (bf16_t*)(R + WB_DN2), lds); conv_ffn(p, 1, 1, (bf16_t*)(R + WB_UP3), (bf16_t*)(R + WB_DN3), lds);
    convT_job(p.in[17], DM, 2048, p.in[6] + DM, (bf16_t*)(R + WB_INO), -1, lds); convT_job(p.in[29], DM, DM, nullptr, (bf16_t*)(R + WB_OUTO), -1, lds);
    GEMM_OUT(ws + WA_OUTE)
    GEMM_UP(ws + WA_UP1) GEMM_DOWN(ws + WA_DN1, p.out)
    GEMM_UP(R + WB_UP2) GEMM_DOWN(R + WB_DN2, p.out)
    { EpiIn ei{BIG, LDPO, rowss}; run_gemm<EpiIn>(lds, X1, (const bf16_t*)(R + WB_INO), 2048, DM, ei); } grid.sync();
    conv_items(p, BIG, Y, lds); lru_items(p, BIG, (float*)X1, (float*)(ws + OFF_CP), aagg, bagg, lds); grid.sync();
    lru_combine(BIG, (const float*)X1, (const float*)(ws + OFF_CP), aagg, bagg, Y); grid.sync();
    GEMM_OUT(R + WB_OUTO)
    GEMM_UP(R + WB_UP3) GEMM_DOWN(R + WB_DN3, p.out)
    final_norm(p.out, p.in[30]);
}

extern "C" void kernel_launch(void* const* d_in, const int* in_sizes, int n_in, void* d_out, int out_size, void* d_ws, size_t ws_size, hipStream_t stream) {
    static int grid_blocks = 0;
    if (!grid_blocks) {
        int dev = 0, cus = 0, per_cu = 0;
        (void)hipGetDevice(&dev);
        (void)hipDeviceGetAttribute(&cus, hipDeviceAttributeMultiprocessorCount, dev);
        (void)hipFuncSetAttribute((const void*)fwd_megakernel, hipFuncAttributeMaxDynamicSharedMemorySize, LDS_BYTES);
        (void)hipOccupancyMaxActiveBlocksPerMultiprocessor(&per_cu, (const void*)fwd_megakernel, 512, LDS_BYTES);
        grid_blocks = cus > 0 ? cus : 256;
        fprintf(stderr, "kernel_launch: cus=%d per_cu=%d grid=%d ws_size=%zu need=%zu n_in=%d\n", cus, per_cu, grid_blocks, ws_size, (size_t)WS_END, n_in);
        if (ws_size < WS_END || n_in != 31) { fprintf(stderr, "kernel_launch: workspace too small or wrong input count; nothing launched\n"); grid_blocks = -1; }
    }
    if (grid_blocks < 0) return;
    Params p{};
    for (int i = 0; i < 31; ++i) p.in[i] = (const float*)d_in[i];
    p.out = (float*)d_out; p.ws = (unsigned char*)d_ws;
    void* args[] = {&p};
    hipError_t e = hipLaunchCooperativeKernel((const void*)fwd_megakernel, dim3(grid_blocks), dim3(512), args, LDS_BYTES, stream);
    if (e != hipSuccess) fprintf(stderr, "cooperative launch failed: %s (grid %d)\n", hipGetErrorString(e), grid_blocks);
}
```

```cpp
#include <hip/hip_runtime.h>
#include <hip/hip_cooperative_groups.h>
#include <cstdio>
namespace cg = cooperative_groups;
namespace pg8 {
#define PG8_LAS __attribute__((address_space(3)))
typedef unsigned short bf16_t;
typedef short bf16x8 __attribute__((ext_vector_type(8)));
typedef float f32x4 __attribute__((ext_vector_type(4)));
typedef unsigned u32x4 __attribute__((ext_vector_type(4)));
constexpr int BM = 256, BK = 64, HALF = 128, HTB = HALF * BK * 2  , STAGE_BYTES = 8 * HTB, NXCD = 8, WGM = 8;

__host__ __device__ __forceinline__ int lds_byte(int r, int c) { const int st = (r >> 4) * 2 + (c >> 5), rr = r & 15, cc = c & 31, ob = rr * 64 + cc * 2; return st * 1024 + (ob ^ (((ob >> 9) & 1) << 5)); }
__host__ __device__ __forceinline__ void stage_rc(int b, int& R, int& C) { const int st = b / 1024, sb = b % 1024, swz = sb ^ (((sb >> 9) & 1) << 5); R = (st >> 1) * 16 + swz / 64; C = (st & 1) * 32 + (swz % 64) / 2; }
__host__ __device__ __forceinline__ int perm32(int rho) { const int n = rho >> 4, i = rho & 15; return 8 * (i >> 2) + 4 * n + (i & 3); }

struct Unit { int pm, pn; };
struct Gemm { const bf16_t* A; const bf16_t* Bt; int M, N, K; };

struct StaticOrder {
    int nM, nN, nwg, G, c;
    __host__ __device__ void init(int M, int N, int G_, int c_) { nM = M / BM; nN = N / BM; nwg = nM * nN; G = G_; c = c_; }
    __host__ __device__ bool next(int i, Unit& u) const {
        const long L = (long)i * G + c; if (L >= nwg) return false;
        int wgid = (int)L; { const int q = nwg / NXCD, r = nwg % NXCD, xcd = wgid % NXCD, off = wgid / NXCD; wgid = (xcd < r ? xcd * (q + 1) : r * (q + 1) + (xcd - r) * q) + off; }
        const int nig = WGM * nN, gid = wgid / nig, fm = gid * WGM, gsz = (nM - fm) < WGM ? (nM - fm) : WGM;
        u.pm = fm + ((wgid % nig) % gsz); u.pn = (wgid % nig) / gsz; return true;
    }
    __device__ __forceinline__ void a_ready(const Unit&) const {}
    __device__ __forceinline__ void done(const Unit&) const {}
};
template <class Epi, class Sched>
__device__ __forceinline__ void gemm_phase(PG8_LAS unsigned char* lds, const Gemm g, const Sched& S, const Epi& E) {
    int tid_l = (int)threadIdx.x; asm volatile("" : "+v"(tid_l));
    const int tid = tid_l, wid = __builtin_amdgcn_readfirstlane(tid >> 6), lane = tid & 63, wr = wid >> 2, wc = wid & 3, fr = lane & 15, fq = lane >> 4;
    const int K = g.K, nt = K / BK;
    unsigned voffA[2], voffB[2];
#pragma unroll
    for (int i = 0; i < 2; ++i) { int R, C; stage_rc(tid * 16 + i * 8192, R, C); const int Rb = Epi::PERM ? ((R & ~31) + perm32(R & 31)) : R;
        voffA[i] = (unsigned)(R * K + C) * 2u; voffB[i] = (unsigned)(Rb * K + C) * 2u; }
    const size_t kstep = (size_t)(BK * 2);
    const size_t hstep = (size_t)HALF * K * 2;
    const size_t tstep = 2 * hstep;
    const unsigned ldsw = (unsigned)wid * 1024u;
    const int aoff = lds_byte(wr * 64 + fr, fq * 8), boff = lds_byte(wc * 32 + fr, fq * 8);
#define PG8_SA(b, h) (((b) * 2 + (h)) * HTB)
#define PG8_SB(b, h) ((4 + (b) * 2 + (h)) * HTB)
#define PG8_STAGE(bufoff, gbase, voff) do { _Pragma("unroll") for (int _i = 0; _i < 2; ++_i) \
        __builtin_amdgcn_global_load_lds((const unsigned*)((const char*)(gbase) + (voff)[_i]), (PG8_LAS unsigned*)(lds + (bufoff) + ldsw + _i * 8192), 16, 0, 0); } while (0)
#define PG8_LDA(dst, b, h) do { _Pragma("unroll") for (int m = 0; m < 4; ++m) _Pragma("unroll") for (int k = 0; k < 2; ++k) dst[m][k] = *(const PG8_LAS bf16x8*)(lds + PG8_SA(b, h) + aoff + m * 2048 + k * 1024); } while (0)
#define PG8_LDB(dst, b, h) do { _Pragma("unroll") for (int n = 0; n < 2; ++n) _Pragma("unroll") for (int k = 0; k < 2; ++k) dst[n][k] = *(const PG8_LAS bf16x8*)(lds + PG8_SB(b, h) + boff + n * 2048 + k * 1024); } while (0)
#define PG8_MMA(ai, bj, At, Bt) do { __builtin_amdgcn_s_setprio(1); _Pragma("unroll") for (int m = 0; m < 4; ++m) _Pragma("unroll") for (int n = 0; n < 2; ++n) _Pragma("unroll") for (int k = 0; k < 2; ++k) \
        acc[ai][bj][m][n] = __builtin_amdgcn_mfma_f32_16x16x32_bf16(Bt[n][k], At[m][k], acc[ai][bj][m][n], 0, 0, 0); __builtin_amdgcn_s_setprio(0); } while (0)
#define PG8_WAIT_V(n) asm volatile("s_waitcnt vmcnt(" #n ")" ::: "memory")
#define PG8_WAIT_L(n) asm volatile("s_waitcnt lgkmcnt(" #n ")" ::: "memory")
#define PG8_BAR __builtin_amdgcn_s_barrier()
#define PG8_SCHED __builtin_amdgcn_sched_barrier(0)
    Unit cur, nxt; int ui = 0;
    if (!S.next(0, cur)) return;
    f32x4 acc[2][2][4][2];
#pragma unroll
    for (int a = 0; a < 2; ++a)
#pragma unroll
        for (int b = 0; b < 2; ++b)
#pragma unroll
            for (int m = 0; m < 4; ++m)
#pragma unroll
                for (int n = 0; n < 2; ++n) acc[a][b][m][n] = (f32x4){0.f, 0.f, 0.f, 0.f};
    bf16x8 At[4][2], B0[2][2], B1[2][2];
    const char* cA = (const char*)g.A + (size_t)cur.pm * tstep; const char* cB = (const char*)g.Bt + (size_t)cur.pn * tstep;
    S.a_ready(cur);
    PG8_STAGE(PG8_SB(0, 0), cB, voffB); PG8_STAGE(PG8_SA(0, 0), cA, voffA); PG8_STAGE(PG8_SB(0, 1), cB + hstep, voffB); PG8_STAGE(PG8_SA(0, 1), cA + hstep, voffA);
    if (wr == 1) PG8_BAR;
    PG8_WAIT_V(4); PG8_BAR;
    PG8_STAGE(PG8_SB(1, 0), cB + kstep, voffB); PG8_STAGE(PG8_SA(1, 0), cA + kstep, voffA); PG8_STAGE(PG8_SB(1, 1), cB + hstep + kstep, voffB);
    PG8_WAIT_V(6); PG8_BAR;
    for (;;) {
        const bool has_next = S.next(ui + 1, nxt);
        const char* nA = has_next ? (const char*)g.A + (size_t)nxt.pm * tstep : cA; const char* nB = has_next ? (const char*)g.Bt + (size_t)nxt.pn * tstep : cB;
        for (int t = 0; t < nt; t += 2) {
            const bool last = (t == nt - 2);
            const char* a1 = cA + (size_t)(t + 1) * kstep;
            const char* a2 = last ? nA : cA + (size_t)(t + 2) * kstep; const char* b2 = last ? nB : cB + (size_t)(t + 2) * kstep;
            const char* a3 = a2 + kstep; const char* b3 = b2 + kstep;
            if (last && has_next) S.a_ready(nxt);
            PG8_LDB(B0, 0, 0); PG8_SCHED; PG8_LDA(At, 0, 0); PG8_STAGE(PG8_SA(1, 1), a1 + hstep, voffA);
            PG8_WAIT_L(8); PG8_BAR; PG8_WAIT_L(0); PG8_MMA(0, 0, At, B0); PG8_BAR; PG8_SCHED;
            PG8_LDB(B1, 0, 1); PG8_STAGE(PG8_SB(0, 0), b2, voffB);
            PG8_BAR; PG8_WAIT_L(0); PG8_MMA(0, 1, At, B1); PG8_BAR;
            PG8_LDA(At, 0, 1); PG8_STAGE(PG8_SA(0, 0), a2, voffA);
            PG8_BAR; PG8_WAIT_L(0); PG8_MMA(1, 0, At, B0); PG8_BAR; PG8_SCHED;
            PG8_STAGE(PG8_SB(0, 1), b2 + hstep, voffB);
            PG8_WAIT_V(6); PG8_BAR; PG8_MMA(1, 1, At, B1); PG8_BAR;
            PG8_LDB(B0, 1, 0); PG8_SCHED; PG8_LDA(At, 1, 0); PG8_STAGE(PG8_SA(0, 1), a2 + hstep, voffA);
            PG8_WAIT_L(8); PG8_BAR; PG8_WAIT_L(0); PG8_MMA(0, 0, At, B0); PG8_BAR; PG8_SCHED;
            PG8_LDB(B1, 1, 1); PG8_STAGE(PG8_SB(1, 0), b3, voffB);
            PG8_BAR; PG8_WAIT_L(0); PG8_MMA(0, 1, At, B1); PG8_BAR;
            PG8_LDA(At, 1, 1); PG8_STAGE(PG8_SA(1, 0), a3, voffA);
            PG8_BAR; PG8_WAIT_L(0); PG8_MMA(1, 0, At, B0); PG8_BAR; PG8_SCHED;
            PG8_STAGE(PG8_SB(1, 1), b3 + hstep, voffB);
            PG8_WAIT_V(6); PG8_BAR; PG8_MMA(1, 1, At, B1); PG8_BAR;
        }
        if constexpr (!Epi::AFTER_DRAIN) { E(acc, cur, wr, wc, fr, fq, ui, lds); S.done(cur); }
        if (!has_next) break;
#pragma unroll
        for (int a = 0; a < 2; ++a)
#pragma unroll
            for (int b = 0; b < 2; ++b)
#pragma unroll
                for (int m = 0; m < 4; ++m)
#pragma unroll
                    for (int n = 0; n < 2; ++n) acc[a][b][m][n] = (f32x4){0.f, 0.f, 0.f, 0.f};
        cur = nxt; cA = nA; cB = nB; ++ui;
    }
    PG8_WAIT_V(0);
    if (wr == 0) PG8_BAR;
    PG8_BAR;
    if constexpr (Epi::AFTER_DRAIN) { E.fused(acc, cur, wr, wc, fr, fq, lds, wid, lane); S.done(cur); }
#undef PG8_SA
#undef PG8_SB
#undef PG8_STAGE
#undef PG8_LDA
#undef PG8_LDB
#undef PG8_MMA
#undef PG8_WAIT_V
#undef PG8_WAIT_L
#undef PG8_BAR
#undef PG8_SCHED
}
}

using pg8::bf16_t; using pg8::bf16x8; using pg8::f32x4; using pg8::u32x4;
typedef unsigned u32x2 __attribute__((ext_vector_type(2)));
typedef float f32x2v __attribute__((ext_vector_type(2)));
typedef short s16x4 __attribute__((ext_vector_type(4)));
#define LAS __attribute__((address_space(3)))
typedef LAS unsigned char* ldsp_t;
__device__ __forceinline__ bf16x8 tr_frag(const LAS bf16_t* tile, int k0, int n0, int fr, int fq) {
    const LAS s16x4* a = (const LAS s16x4*)(tile + (k0 + 8 * fq + (fr >> 2)) * 136 + n0 + 4 * (fr & 3));
    const s16x4 r0 = __builtin_amdgcn_ds_read_tr16_b64_v4i16((LAS s16x4*)a), r1 = __builtin_amdgcn_ds_read_tr16_b64_v4i16((LAS s16x4*)(a + 136));
    return (bf16x8){r0[0], r0[1], r0[2], r0[3], r1[0], r1[1], r1[2], r1[3]};
}

constexpr int DM = 1024, DFF = 2816, SEQ = 4096;
constexpr int MMAIN = 32768, MPAD = 33024;
constexpr int LDPE = 3328, LDPO = 2048;
constexpr int NCH = 65;
constexpr float EPS = 1e-6f;
constexpr int LDS_BYTES = 155648;
constexpr int POOL_SPLIT = 1492;
constexpr int RSTD_TAB_OFF = 131072;

constexpr size_t SZ_UP = (size_t)5632 * 1024 * 2, SZ_DN = (size_t)1024 * 2816 * 2, SZ_INE = (size_t)3328 * 1024 * 2, SZ_SQ = (size_t)1024 * 1024 * 2, SZ_INO = (size_t)2048 * 1024 * 2;
constexpr size_t WA_UP0 = 0, WA_DN0 = WA_UP0 + SZ_UP, WA_UP1 = WA_DN0 + SZ_DN, WA_DN1 = WA_UP1 + SZ_UP, WA_INE = WA_DN1 + SZ_DN, WA_OUTE = WA_INE + SZ_INE, SZ_WA = WA_OUTE + SZ_SQ;
constexpr size_t SZ_XB = (size_t)MPAD * 1024 * 2;
constexpr size_t OFF_X1 = SZ_WA, OFF_Y = OFF_X1 + SZ_XB, OFF_BIG = OFF_Y + SZ_XB, SZ_BIG = (size_t)MPAD * 3328 * 2, OFF_R = OFF_BIG + SZ_BIG, SZ_R = (size_t)48 * 65 * 16384 * 2;
constexpr size_t OFF_HMETA = OFF_R + SZ_R, OFF_ROWSS = OFF_HMETA + (size_t)256 * 1024 * 4, OFF_DEC = OFF_ROWSS + (size_t)MPAD * 16 * 4, OFF_AAGG = OFF_DEC + (size_t)48 * 65 * 128 * 4,
                 OFF_BAGG = OFF_AAGG + (size_t)8 * 65 * 512 * 4, WS_END = OFF_BAGG + (size_t)8 * 65 * 512 * 4;
constexpr size_t OFF_BAR = WS_END;
constexpr size_t OFF_FCNT = WS_END + 16384;
constexpr size_t WB_UP2 = 0, WB_DN2 = WB_UP2 + SZ_UP, WB_UP3 = WB_DN2 + SZ_DN, WB_DN3 = WB_UP3 + SZ_UP, WB_INO = WB_DN3 + SZ_DN, WB_OUTO = WB_INO + SZ_INO;
constexpr size_t OFF_CP = OFF_BIG + (size_t)MPAD * 2048 * 2;

struct Params { const float* in[31]; float* out; unsigned char* ws; int nrep; int pad; };

__device__ __forceinline__ int opaque_tid() { int t = (int)threadIdx.x; asm volatile("" : "+v"(t)); return t; }
__device__ __forceinline__ void lds_sync() { asm volatile("s_waitcnt lgkmcnt(0)\n\ts_barrier" ::: "memory"); }
__device__ __forceinline__ float bf2f(unsigned v) { return __uint_as_float(v << 16); }
__device__ __forceinline__ unsigned pack2_hw(float lo, float hi) { unsigned r; asm("v_cvt_pk_bf16_f32 %0, %1, %2" : "=v"(r) : "v"(lo), "v"(hi)); return r; }
__device__ __forceinline__ unsigned f2bf_sw(float f) { unsigned u = __float_as_uint(f); u += 0x7FFFu + ((u >> 16) & 1u); return u >> 16; }
__device__ __forceinline__ unsigned pack2_sw(float lo, float hi) { return f2bf_sw(lo) | (f2bf_sw(hi) << 16); }
#ifndef HWCVT_MASK
#define HWCVT_MASK 15
#endif
template <int G> __device__ __forceinline__ unsigned pack2g(float lo, float hi) { if ((HWCVT_MASK >> G) & 1) return pack2_hw(lo, hi); else return pack2_sw(lo, hi); }
template <int G> __device__ __forceinline__ unsigned f2bfg(float f) { if ((HWCVT_MASK >> G) & 1) return pack2_hw(f, 0.0f) & 0xffffu; else return f2bf_sw(f); }
#define pack2 pack2g<CVG>
#define f2bf f2bfg<CVG>
#define CVG 0
__device__ __forceinline__ float lo16(unsigned w) { return __uint_as_float(w << 16); }
__device__ __forceinline__ float hi16(unsigned w) { return __uint_as_float(w & 0xffff0000u); }
__device__ __forceinline__ float sigm(float x) { return __builtin_amdgcn_rcpf(1.0f + __expf(-x)); }
__device__ __forceinline__ float silu(float x) { return x * sigm(x); }
__device__ __forceinline__ float gelu_tanh(float x) { const float y = 0.7978845608028654f * (x + 0.044715f * x * x * x); const float t = 1.0f - 2.0f * __builtin_amdgcn_rcpf(1.0f + __expf(2.0f * y)); return 0.5f * x * (1.0f + t); }
__device__ __forceinline__ int row_of(int b, int t) { return t < 16 ? MMAIN + t : b * SEQ + (t - 16); }

__device__ __forceinline__ float row_rstd(const float* rowss, int row, int fq) {
    const f32x4 p = *(const f32x4*)(rowss + (size_t)row * 16 + 4 * fq);
    float s = (p[0] + p[1]) + (p[2] + p[3]);
    s += __shfl_xor(s, 16); s += __shfl_xor(s, 32);
    return rsqrtf(s * (1.0f / 1024.0f) + EPS);
}

struct EpiUp {
    static constexpr bool PERM = false, AFTER_DRAIN = false;
    bf16_t* act; const float* rowss;
    __device__ __forceinline__ void operator()(const f32x4 (&acc)[2][2][4][2], const pg8::Unit& u, int wr, int wc, int fr, int fq, int ui, ldsp_t lds) const {
        const LAS float* rtab = (const LAS float*)(lds + RSTD_TAB_OFF) + ui * 256 + wr * 64 + fr;
        const int row0 = u.pm * 256 + wr * 64 + fr, j0 = u.pn * 128 + wc * 16 + 4 * fq;
#pragma unroll
        for (int ai = 0; ai < 2; ++ai)
#pragma unroll
            for (int m = 0; m < 4; ++m) {
                const int row = row0 + ai * 128 + m * 16; const float rs = rtab[ai * 128 + m * 16]; bf16_t* rp = act + (size_t)row * DFF + j0;
#pragma unroll
                for (int bj = 0; bj < 2; ++bj) {
                    const f32x4 g = acc[ai][bj][m][0] * rs, uu = acc[ai][bj][m][1] * rs; const f32x4 t = g * -1.4426950408889634f;
                    f32x4 e; e[0] = __builtin_amdgcn_exp2f(t[0]); e[1] = __builtin_amdgcn_exp2f(t[1]); e[2] = __builtin_amdgcn_exp2f(t[2]); e[3] = __builtin_amdgcn_exp2f(t[3]);
                    const f32x4 d = e + 1.0f; f32x4 r; r[0] = __builtin_amdgcn_rcpf(d[0]); r[1] = __builtin_amdgcn_rcpf(d[1]); r[2] = __builtin_amdgcn_rcpf(d[2]); r[3] = __builtin_amdgcn_rcpf(d[3]);
                    const f32x4 o = (g * uu) * r;
                    u32x2 w; w.x = pack2(o[0], o[1]); w.y = pack2(o[2], o[3]);
                    *(u32x2*)(rp + bj * 64) = w; }
            }
    }
};
struct EpiIn {
    static constexpr bool PERM = false, AFTER_DRAIN = false;
    bf16_t* P; int ldp; const float* rowss;
    __device__ __forceinline__ void operator()(const f32x4 (&acc)[2][2][4][2], const pg8::Unit& u, int wr, int wc, int fr, int fq, int ui, ldsp_t lds) const {
        const LAS float* rtab = (const LAS float*)(lds + RSTD_TAB_OFF) + ui * 256 + wr * 64 + fr;
        const int row0 = u.pm * 256 + wr * 64 + fr, col0 = u.pn * 256 + wc * 32 + 4 * fq;
#pragma unroll
        for (int ai = 0; ai < 2; ++ai)
#pragma unroll
            for (int m = 0; m < 4; ++m) {
                const int row = row0 + ai * 128 + m * 16; const float rs = rtab[ai * 128 + m * 16]; bf16_t* rp = P + (size_t)row * ldp + col0;
#pragma unroll
                for (int bj = 0; bj < 2; ++bj)
#pragma unroll
                    for (int n = 0; n < 2; ++n) { const f32x4 v = acc[ai][bj][m][n] * rs; u32x2 w; w.x = pack2(v[0], v[1]); w.y = pack2(v[2], v[3]); *(u32x2*)(rp + bj * 128 + n * 16) = w; }
            }
    }
};
struct EpiRes {
    static constexpr bool PERM = false, AFTER_DRAIN = false;
    const float* base; float* h; bf16_t* hb; float* rowss; float alpha;
    __device__ __forceinline__ void operator()(const f32x4 (&acc)[2][2][4][2], const pg8::Unit& u, int wr, int wc, int fr, int fq, int, ldsp_t) const {
        const int row0 = u.pm * 256 + wr * 64 + fr, col0 = u.pn * 256 + wc * 32 + 4 * fq;
#pragma unroll
        for (int ai = 0; ai < 2; ++ai) {
            f32x4 bv[4][2][2];
#pragma unroll
            for (int m = 0; m < 4; ++m)
#pragma unroll
                for (int bj = 0; bj < 2; ++bj)
#pragma unroll
                    for (int n = 0; n < 2; ++n) bv[m][bj][n] = *(const f32x4*)(base + (size_t)(row0 + ai * 128 + m * 16) * 1024 + col0 + bj * 128 + n * 16);
            asm volatile("" ::: "memory");
#pragma unroll
            for (int m = 0; m < 4; ++m) {
                const int row = row0 + ai * 128 + m * 16; const size_t off = (size_t)row * 1024 + col0; float ss = 0.f;
#pragma unroll
                for (int bj = 0; bj < 2; ++bj)
#pragma unroll
                    for (int n = 0; n < 2; ++n) { const size_t o = off + bj * 128 + n * 16; const f32x4 hv = bv[m][bj][n] + alpha * acc[ai][bj][m][n];
                        *(f32x4*)(h + o) = hv; u32x2 w; w.x = pack2(hv[0], hv[1]); w.y = pack2(hv[2], hv[3]); *(u32x2*)(hb + o) = w;
                        ss += (hv[0] * hv[0] + hv[1] * hv[1]) + (hv[2] * hv[2] + hv[3] * hv[3]); }
                ss += __shfl_xor(ss, 16); ss += __shfl_xor(ss, 32);
                if (fq == 0) rowss[(size_t)row * 16 + u.pn * 4 + wc] = ss;
            }
        }
    }
};

struct EpiFinal {
    static constexpr bool PERM = false, AFTER_DRAIN = false;
    const float* base; float* out; float* xch; unsigned* cnt; const float* gain; float alpha;
    __device__ __forceinline__ void operator()(const f32x4 (&acc)[2][2][4][2], const pg8::Unit& u, int wr, int wc, int fr, int fq, int, ldsp_t) const {
        const int row0 = u.pm * 256 + wr * 64 + fr, col0 = u.pn * 256 + wc * 32 + 4 * fq;
        f32x4 (&hw)[2][2][4][2] = const_cast<f32x4 (&)[2][2][4][2]>(acc);
#pragma unroll
        for (int ai = 0; ai < 2; ++ai) {
            f32x4 bv[4][2][2];
#pragma unroll
            for (int m = 0; m < 4; ++m)
#pragma unroll
                for (int bj = 0; bj < 2; ++bj)
#pragma unroll
                    for (int n = 0; n < 2; ++n) bv[m][bj][n] = *(const f32x4*)(base + (size_t)(row0 + ai * 128 + m * 16) * 1024 + col0 + bj * 128 + n * 16);
            asm volatile("" ::: "memory");
#pragma unroll
            for (int m = 0; m < 4; ++m) {
                const int row = row0 + ai * 128 + m * 16; float ss = 0.f;
#pragma unroll
                for (int bj = 0; bj < 2; ++bj)
#pragma unroll
                    for (int n = 0; n < 2; ++n) { const f32x4 h4 = bv[m][bj][n] + alpha * acc[ai][bj][m][n]; hw[ai][bj][m][n] = h4; ss += (h4[0] * h4[0] + h4[1] * h4[1]) + (h4[2] * h4[2] + h4[3] * h4[3]); }
                ss += __shfl_xor(ss, 16); ss += __shfl_xor(ss, 32);
                if (fq == 0) __hip_atomic_store(xch + (size_t)row * 16 + u.pn * 4 + wc, ss, __ATOMIC_RELAXED, __HIP_MEMORY_SCOPE_AGENT);
            }
        }
        asm volatile("s_waitcnt vmcnt(0)" ::: "memory");
        unsigned* cp = cnt + (size_t)(u.pm * 2 + wr) * 16;
        if ((fr | fq) == 0) __hip_atomic_fetch_add(cp, 1u, __ATOMIC_RELAXED, __HIP_MEMORY_SCOPE_AGENT);
        { unsigned sp = 0;
          while ((unsigned)__builtin_amdgcn_readfirstlane(__hip_atomic_load(cp, __ATOMIC_RELAXED, __HIP_MEMORY_SCOPE_AGENT)) < 16u) { __builtin_amdgcn_s_sleep(1); if (++sp > (1u << 18)) break; } }
        asm volatile("" ::: "memory");
        f32x4 gv[2][2];
#pragma unroll
        for (int bj = 0; bj < 2; ++bj)
#pragma unroll
            for (int n = 0; n < 2; ++n) gv[bj][n] = *(const f32x4*)(gain + col0 + bj * 128 + n * 16);
#pragma unroll
        for (int ai = 0; ai < 2; ++ai)
#pragma unroll
            for (int m = 0; m < 4; ++m) {
                const int row = row0 + ai * 128 + m * 16; const float* xp = xch + (size_t)row * 16 + 4 * fq;
                float s = (__hip_atomic_load(xp, __ATOMIC_RELAXED, __HIP_MEMORY_SCOPE_AGENT) + __hip_atomic_load(xp + 1, __ATOMIC_RELAXED, __HIP_MEMORY_SCOPE_AGENT)) + (__hip_atomic_load(xp + 2, __ATOMIC_RELAXED, __HIP_MEMORY_SCOPE_AGENT) + __hip_atomic_load(xp + 3, __ATOMIC_RELAXED, __HIP_MEMORY_SCOPE_AGENT));
                s += __shfl_xor(s, 16); s += __shfl_xor(s, 32);
                const float rs = rsqrtf(s * (1.0f / 1024.0f) + EPS);
#pragma unroll
                for (int bj = 0; bj < 2; ++bj)
#pragma unroll
                    for (int n = 0; n < 2; ++n) *(f32x4*)(out + (size_t)row * 1024 + col0 + bj * 128 + n * 16) = hw[ai][bj][m][n] * rs * gv[bj][n];
            }
    }
};

__device__ __forceinline__ f32x4 mfma16(bf16x8 a, bf16x8 b, f32x4 c) { return __builtin_amdgcn_mfma_f32_16x16x32_bf16(a, b, c, 0, 0, 0); }
template <int MODE, int NS>
__device__ __noinline__ void meta_gemm(ldsp_t lds, const bf16_t* A, const bf16_t* Bt, int ntasks, float* hmeta, bf16_t* outb, int ldo, float alpha) {
    constexpr int K = 256 * NS;
    LAS float* part = (LAS float*)lds;
    LAS float* rs = (LAS float*)(lds + 16384);
    const int tid = opaque_tid(), lane = tid & 63, w = tid >> 6, fr = lane & 15, fq = lane >> 4;
    for (int t = blockIdx.x; t < ntasks; t += gridDim.x) {
        bf16x8 av[NS], bv[NS], bw[MODE == 0 ? NS : 1];
        { const bf16_t* ap = A + (size_t)fr * K + 8 * fq + 32 * w;
          const bf16_t* b0 = Bt + (size_t)((MODE == 0 ? 32 * t : 16 * t) + fr) * K + 8 * fq + 32 * w;
#pragma unroll
          for (int i = 0; i < NS; ++i) { av[i] = *(const bf16x8*)(ap + 256 * i); bv[i] = *(const bf16x8*)(b0 + 256 * i); if (MODE == 0) bw[i] = *(const bf16x8*)(b0 + (size_t)16 * K + 256 * i); } }
        if (MODE != 2) {
#pragma unroll
            for (int rr = 0; rr < 2; ++rr) { const int row = 2 * w + rr; float ss = 0.f;
#pragma unroll
                for (int i = 0; i < 4; ++i) { const f32x4 v = *(const f32x4*)(hmeta + (size_t)row * DM + i * 256 + lane * 4); ss += (v[0] * v[0] + v[1] * v[1]) + (v[2] * v[2] + v[3] * v[3]); }
#pragma unroll
                for (int o = 32; o >= 1; o >>= 1) ss += __shfl_xor(ss, o);
                if (lane == 0) rs[row] = rsqrtf(ss * (1.0f / 1024.0f) + EPS); }
        }
        f32x4 acc0 = {0.f, 0.f, 0.f, 0.f}, acc1 = {0.f, 0.f, 0.f, 0.f};
#pragma unroll
        for (int i = 0; i < NS; ++i) { acc0 = mfma16(av[i], bv[i], acc0); if (MODE == 0) acc1 = mfma16(av[i], bw[i], acc1); }
        *(LAS f32x4*)(part + ((w * 2 + 0) * 64 + lane) * 4) = acc0; if (MODE == 0) *(LAS f32x4*)(part + ((w * 2 + 1) * 64 + lane) * 4) = acc1;
        __syncthreads();
        if (tid < 256) { const int e = tid & 3, ln = tid >> 2; float s0 = 0.f, s1 = 0.f;
#pragma unroll
            for (int ww = 0; ww < 8; ++ww) { s0 += part[((ww * 2 + 0) * 64 + ln) * 4 + e]; if (MODE == 0) s1 += part[((ww * 2 + 1) * 64 + ln) * 4 + e]; }
            const int row = 4 * (ln >> 4) + e, col = 16 * t + (ln & 15);
            if (MODE == 0) { const float r = rs[row]; outb[(size_t)(MMAIN + row) * ldo + col] = (bf16_t)f2bf(silu(s0 * r) * (s1 * r)); }
            else if (MODE == 1) { outb[(size_t)(MMAIN + row) * ldo + col] = (bf16_t)f2bf(s0 * rs[row]); }
            else { const float hv = hmeta[(size_t)row * DM + col] + alpha * s0; hmeta[(size_t)row * DM + col] = hv; outb[(size_t)(MMAIN + row) * ldo + col] = (bf16_t)f2bf(hv); } }
        __syncthreads();
    }
}

#undef CVG
#define CVG 1
__device__ void convT_job(const float* __restrict__ src, int K, int N, const float* __restrict__ gain, bf16_t* __restrict__ dst, int which, ldsp_t) {
    const int tid_ = opaque_tid(); const int lane = tid_ & 63, gw = blockIdx.x * 8 + (tid_ >> 6), nw = gridDim.x * 8;
    const int nnb = N >> 6, ntask = (K >> 5) * nnb;
    float v[32], nv[32];
#define CONVT_LOAD(DST, T) { const float* sp_ = src + (size_t)(((T) / nnb) << 5) * N + (((T) % nnb) << 6) + lane; \
        _Pragma("unroll") for (int i = 0; i < 32; ++i) DST[i] = sp_[(size_t)i * N]; }
    int t = gw;
    if (t < ntask) CONVT_LOAD(v, t)
    while (t < ntask) {
        const int nt = t + nw;
        if (nt < ntask) CONVT_LOAD(nv, nt)
        asm volatile("" ::: "memory");
        const int k0 = (t / nnb) << 5, j = ((t % nnb) << 6) + lane;
        if (gain) {
#pragma unroll
            for (int i = 0; i < 32; i += 4) { const f32x4 g = *(const f32x4*)(gain + k0 + i); v[i] *= g[0]; v[i + 1] *= g[1]; v[i + 2] *= g[2]; v[i + 3] *= g[3]; } }
        const int drow = which < 0 ? j : ((j >> 4) * 32 + which * 16 + (j & 15));
        bf16_t* dp = dst + (size_t)drow * K + k0;
#pragma unroll
        for (int i = 0; i < 32; i += 8) { u32x4 w; w.x = pack2(v[i], v[i + 1]); w.y = pack2(v[i + 2], v[i + 3]); w.z = pack2(v[i + 4], v[i + 5]); w.w = pack2(v[i + 6], v[i + 7]); *(u32x4*)(dp + i) = w; }
#pragma unroll
        for (int i = 0; i < 32; ++i) v[i] = nv[i];
        t = nt;
    }
#undef CONVT_LOAD
}
__device__ void conv_ffn(const Params& p, int l, int second, bf16_t* up, bf16_t* dn, ldsp_t lds) {
    const float* nrm = p.in[second ? 7 : 2] + (size_t)l * DM;
    const float* wg = p.in[second ? 8 : 3] + (size_t)l * DM * DFF; const float* wu = p.in[second ? 9 : 4] + (size_t)l * DM * DFF; const float* wd = p.in[second ? 10 : 5] + (size_t)l * DFF * DM;
    convT_job(wg, DM, DFF, nrm, up, 0, lds); convT_job(wu, DM, DFF, nrm, up, 1, lds); convT_job(wd, DFF, DM, nullptr, dn, -1, lds);
}
__device__ void prep_rows(const Params& p, bf16_t* __restrict__ HB, float* __restrict__ rowss, float* __restrict__ hmeta) {
    const int tid_ = opaque_tid(); const int lane = tid_ & 63, gw = blockIdx.x * 8 + (tid_ >> 6), nw = gridDim.x * 8;
    f32x4 v[4], nv[4];
#define PREP_LOAD(DST, ROW) { const float* src_ = (ROW) < MMAIN ? p.in[0] + (size_t)(ROW) * DM : ((ROW) < MMAIN + 16 ? p.in[1] + (size_t)((ROW) - MMAIN) * DM : nullptr); \
        _Pragma("unroll") for (int i = 0; i < 4; ++i) { DST[i] = (f32x4){0.f, 0.f, 0.f, 0.f}; if (src_) DST[i] = *(const f32x4*)(src_ + i * 256 + lane * 4); } }
    int row = gw;
    if (row < MPAD) PREP_LOAD(v, row)
    while (row < MPAD) {
        const int nrow = row + nw;
        if (nrow < MPAD) PREP_LOAD(nv, nrow)
        float ss = 0.f;
#pragma unroll
        for (int i = 0; i < 4; ++i) { const int col = i * 256 + lane * 4;
            ss += (v[i][0] * v[i][0] + v[i][1] * v[i][1]) + (v[i][2] * v[i][2] + v[i][3] * v[i][3]);
            u32x2 w; w.x = pack2(v[i][0], v[i][1]); w.y = pack2(v[i][2], v[i][3]); *(u32x2*)(HB + (size_t)row * DM + col) = w;
            if (row >= MMAIN) *(f32x4*)(hmeta + (size_t)(row - MMAIN) * DM + col) = v[i]; }
#pragma unroll
        for (int o = 32; o >= 1; o >>= 1) ss += __shfl_xor(ss, o);
        if (lane < 16) rowss[(size_t)row * 16 + lane] = lane == 0 ? ss : 0.f;
#pragma unroll
        for (int i = 0; i < 4; ++i) v[i] = nv[i];
        row = nrow;
    }
#undef PREP_LOAD
}

#undef CVG
#define CVG 2
__device__ void hg_phaseA(const Params& p, const bf16_t* P, bf16_t* states, float* dec, ldsp_t lds) {
    LAS float* Lb = (LAS float*)lds;
    LAS bf16_t* Z = (LAS bf16_t*)(lds + 32768);
    LAS bf16_t* VT = (LAS bf16_t*)(lds + 49152);
    LAS bf16_t* KlT = (LAS bf16_t*)(lds + 49152 + 18432);
    LAS float* Tot = (LAS float*)(lds + 49152 + 36864);
    const int tid = opaque_tid(), lane = tid & 63, w = __builtin_amdgcn_readfirstlane(tid >> 6), fr = lane & 15, fq = lane >> 4;
    const float* lbl = p.in[14];
    const int NIT = 48 * 64;
    float lb6a[6], lb6b[6];
#pragma unroll
    for (int hq = 0; hq < 6; ++hq) { lb6a[hq] = sigm(lbl[128 * hq + 2 * lane] - lbl[768 + 128 * hq + 2 * lane]); lb6b[hq] = sigm(lbl[128 * hq + 2 * lane + 1] - lbl[768 + 128 * hq + 2 * lane + 1]); }
    u32x4 pz[2], pv[2];
#define EA_LOAD(IT) { const int c_ = (IT) & 63, bh_ = (IT) >> 6, b_ = bh_ / 6, h_ = bh_ % 6; \
        _Pragma("unroll") for (int i = 0; i < 2; ++i) { const int idx = tid + 512 * i, s = idx >> 4, c8 = (idx & 15) * 8; const bool valid = c_ > 0 || s < 16; \
            const int row = c_ == 0 ? MMAIN + s : b_ * SEQ + 64 * (c_ - 1) + s; pz[i] = (u32x4){0u, 0u, 0u, 0u}; pv[i] = (u32x4){0u, 0u, 0u, 0u}; \
            if (valid) { pz[i] = *(const u32x4*)(P + (size_t)row * LDPE + 1024 + 128 * h_ + c8); pv[i] = *(const u32x4*)(P + (size_t)row * LDPE + 1792 + 128 * h_ + c8); } } }
    int it = blockIdx.x;
    if (it < NIT) EA_LOAD(it)
    while (it < NIT) {
        const int c = it & 63, bh = it >> 6, h = bh % 6;
#pragma unroll
        for (int i = 0; i < 2; ++i) {
            const int idx = tid + 512 * i, s = idx >> 4, c8 = (idx & 15) * 8;
            *(LAS u32x4*)(Z + s * 128 + c8) = pz[i];
            *(LAS u32x4*)(VT + s * 136 + c8) = pv[i];
        }
        lds_sync();
        const int nit = it + (int)gridDim.x;
        if (nit < NIT) EA_LOAD(nit)
        const float lbA = h == 0 ? lb6a[0] : (h == 1 ? lb6a[1] : (h == 2 ? lb6a[2] : (h == 3 ? lb6a[3] : (h == 4 ? lb6a[4] : lb6a[5]))));
        const float lbB = h == 0 ? lb6b[0] : (h == 1 ? lb6b[1] : (h == 2 ? lb6b[2] : (h == 3 ? lb6b[3] : (h == 4 ? lb6b[4] : lb6b[5]))));
        {
            float runA = 0.f, runB = 0.f;
#pragma unroll
            for (int q = 0; q < 8; ++q) { const int s = 8 * w + q; const bool valid = c > 0 || s < 16; const unsigned zz = *(const LAS unsigned*)(Z + s * 128 + 2 * lane);
                const float sgA = sigm(lo16(zz)), sgB = sigm(hi16(zz)); const float fA = lbA + (1.0f - lbA) * sgA, fB = lbB + (1.0f - lbB) * sgB;
                runA += valid ? __logf(fA) : 0.f; runB += valid ? __logf(fB) : 0.f;
                *(LAS f32x2v*)(Lb + s * 128 + 2 * lane) = (f32x2v){runA, runB};
                *(LAS unsigned*)(Z + s * 128 + 2 * lane) = pack2(valid ? (1.0f - lbA) * (1.0f - sgA) : 0.f, valid ? (1.0f - lbB) * (1.0f - sgB) : 0.f); }
            *(LAS f32x2v*)(Tot + w * 128 + 2 * lane) = (f32x2v){runA, runB};
        }
        lds_sync();
        {
            f32x2v T[8];
#pragma unroll
            for (int g = 0; g < 8; ++g) T[g] = *(const LAS f32x2v*)(Tot + g * 128 + 2 * lane);
            f32x2v tail = {0.f, 0.f};
#pragma unroll
            for (int g = 7; g >= 0; --g) { if (g > w) tail += T[g]; }
            f32x2v mine = {0.f, 0.f};
#pragma unroll
            for (int g = 0; g < 8; ++g) { if (g == w) mine = T[g]; }
            float klA[8], klB[8];
#pragma unroll
            for (int q = 0; q < 8; ++q) { const int s = 8 * w + q; const unsigned kz = *(const LAS unsigned*)(Z + s * 128 + 2 * lane); const f32x2v lc = *(const LAS f32x2v*)(Lb + s * 128 + 2 * lane);
                klA[q] = lo16(kz) * __expf(tail[0] + (mine[0] - lc[0])); klB[q] = hi16(kz) * __expf(tail[1] + (mine[1] - lc[1])); }
            u32x4 wA = {pack2(klA[0], klA[1]), pack2(klA[2], klA[3]), pack2(klA[4], klA[5]), pack2(klA[6], klA[7])}, wB = {pack2(klB[0], klB[1]), pack2(klB[2], klB[3]), pack2(klB[4], klB[5]), pack2(klB[6], klB[7])};
            *(LAS u32x4*)(KlT + (2 * lane) * 72 + 8 * w) = wA; *(LAS u32x4*)(KlT + (2 * lane + 1) * 72 + 8 * w) = wB;
            if (w == 0) { f32x2v bl = {0.f, 0.f};
#pragma unroll
                for (int g = 0; g < 8; ++g) bl += T[g];
                *(f32x2v*)(dec + ((size_t)bh * NCH + c) * 128 + 2 * lane) = (f32x2v){__expf(bl[0]), __expf(bl[1])}; }
        }
        lds_sync();
        {
            f32x4 acc[8];
#pragma unroll
            for (int vb = 0; vb < 8; ++vb) acc[vb] = (f32x4){0.f, 0.f, 0.f, 0.f};
#pragma unroll
            for (int kk = 0; kk < 2; ++kk) {
                const bf16x8 a = *(const LAS bf16x8*)(KlT + (16 * w + fr) * 72 + 32 * kk + 8 * fq);
#pragma unroll
                for (int vb = 0; vb < 8; ++vb) { const bf16x8 bb = tr_frag(VT, 32 * kk, 16 * vb, fr, fq); acc[vb] = mfma16(a, bb, acc[vb]); }
            }
            bf16_t* st = states + ((size_t)bh * NCH + c) * 16384;
            float one = 1.0f; asm volatile("" : "+v"(one));
#pragma unroll
            for (int vb = 0; vb < 8; ++vb) { const f32x4 av = acc[vb] * one; u32x2 o; o.x = pack2(av[0], av[1]); o.y = pack2(av[2], av[3]); *(u32x2*)(st + (16 * vb + fr) * 128 + 16 * w + 4 * fq) = o; }
        }
        lds_sync();
        it = nit;
    }
#undef EA_LOAD
}

__device__ void hg_phaseB(bf16_t* __restrict__ states, const float* __restrict__ dec) {
    const int idx = blockIdx.x * 512 + opaque_tid();
    if (idx >= 48 * 2048) return;
    const int bh = idx >> 11, e8 = idx & 2047, k0 = (e8 & 15) * 8;
    bf16_t* sp = states + (size_t)bh * NCH * 16384 + (size_t)e8 * 8; const float* dp = dec + (size_t)bh * NCH * 128 + k0;
    float S[8];
#pragma unroll
    for (int e = 0; e < 8; ++e) S[e] = 0.f;
    u32x4 u[4], nu[4]; f32x4 d0[4], d1[4], nd0[4], nd1[4];
#pragma unroll
    for (int j = 0; j < 4; ++j) { u[j] = *(const u32x4*)(sp + (size_t)j * 16384); d0[j] = *(const f32x4*)(dp + j * 128); d1[j] = *(const f32x4*)(dp + j * 128 + 4); }
    for (int c0 = 0; c0 < 64; c0 += 4) {
        if (c0 + 4 < 64) {
#pragma unroll
            for (int j = 0; j < 4; ++j) { nu[j] = *(const u32x4*)(sp + (size_t)(c0 + 4 + j) * 16384); nd0[j] = *(const f32x4*)(dp + (c0 + 4 + j) * 128); nd1[j] = *(const f32x4*)(dp + (c0 + 4 + j) * 128 + 4); }
        }
#pragma unroll
        for (int j = 0; j < 4; ++j) {
            u32x4 o; o.x = pack2(S[0], S[1]); o.y = pack2(S[2], S[3]); o.z = pack2(S[4], S[5]); o.w = pack2(S[6], S[7]);
            *(u32x4*)(sp + (size_t)(c0 + j) * 16384) = o;
            S[0] = d0[j][0] * S[0] + lo16(u[j].x); S[1] = d0[j][1] * S[1] + hi16(u[j].x); S[2] = d0[j][2] * S[2] + lo16(u[j].y); S[3] = d0[j][3] * S[3] + hi16(u[j].y);
            S[4] = d1[j][0] * S[4] + lo16(u[j].z); S[5] = d1[j][1] * S[5] + hi16(u[j].z); S[6] = d1[j][2] * S[6] + lo16(u[j].w); S[7] = d1[j][3] * S[7] + hi16(u[j].w);
        }
#pragma unroll
        for (int j = 0; j < 4; ++j) { u[j] = nu[j]; d0[j] = nd0[j]; d1[j] = nd1[j]; }
    }
    u32x4 o; o.x = pack2(S[0], S[1]); o.y = pack2(S[2], S[3]); o.z = pack2(S[4], S[5]); o.w = pack2(S[6], S[7]);
    *(u32x4*)(sp + (size_t)64 * 16384) = o;
}

__device__ __forceinline__ void hg_phaseC(const Params& p, const bf16_t* P, const bf16_t* states, bf16_t* Y, ldsp_t lds, int it_first, int it_stride, bool skipc0) {
    LAS float* Lb = (LAS float*)lds;
    LAS bf16_t* Z = (LAS bf16_t*)(lds + 32768);
    LAS bf16_t* Qb = (LAS bf16_t*)(lds + 49152);
    LAS bf16_t* Qd = (LAS bf16_t*)(lds + 66560);
    LAS bf16_t* Kd = (LAS bf16_t*)(lds + 83968);
    LAS bf16_t* VT = (LAS bf16_t*)(lds + 127488);
    LAS bf16_t* Am = (LAS bf16_t*)(lds + 145920);
    LAS float* Tot = (LAS float*)(lds + 145920);
    LAS float* O = (LAS float*)lds;
    const int tid = opaque_tid(), lane = tid & 63, w = __builtin_amdgcn_readfirstlane(tid >> 6), fr = lane & 15, fq = lane >> 4;
    const float* lbl = p.in[14]; const float* gnorm = p.in[15];
    const int NIT = 48 * NCH;
    float lb6a[6], lb6b[6];
#pragma unroll
    for (int hq = 0; hq < 6; ++hq) { lb6a[hq] = sigm(lbl[128 * hq + 2 * lane] - lbl[768 + 128 * hq + 2 * lane]); lb6b[hq] = sigm(lbl[128 * hq + 2 * lane + 1] - lbl[768 + 128 * hq + 2 * lane + 1]); }
    u32x4 pq[2], pz[2], pv[2];
#define EC_SKIP(IT) (skipc0 && ((IT) % NCH) == 0)
#define EC_LOAD(IT) { const int c_ = (IT) % NCH, bh_ = (IT) / NCH, b_ = bh_ / 6, h_ = bh_ % 6; \
        _Pragma("unroll") for (int i = 0; i < 2; ++i) { const int idx = tid + 512 * i, s = idx >> 4, c8 = (idx & 15) * 8; const bool valid = c_ > 0 || s < 16; \
            const int row = c_ == 0 ? MMAIN + s : b_ * SEQ + 64 * (c_ - 1) + s; pq[i] = (u32x4){0u, 0u, 0u, 0u}; pz[i] = (u32x4){0u, 0u, 0u, 0u}; pv[i] = (u32x4){0u, 0u, 0u, 0u}; \
            if (valid) { const bf16_t* pr = P + (size_t)row * LDPE + 128 * h_ + c8; pq[i] = *(const u32x4*)(pr + 256); pz[i] = *(const u32x4*)(pr + 1024); pv[i] = *(const u32x4*)(pr + 1792); } } }
    int it = it_first;
    while (it < NIT && EC_SKIP(it)) it += it_stride;
    if (it < NIT) EC_LOAD(it)
    while (it < NIT) {
        const int c = it % NCH, bh = it / NCH, b = bh / 6, h = bh % 6;
#pragma unroll
        for (int i = 0; i < 2; ++i) {
            const int idx = tid + 512 * i, s = idx >> 4, c8 = (idx & 15) * 8;
            *(LAS u32x4*)(Z + s * 128 + c8) = pz[i]; *(LAS u32x4*)(Qd + s * 136 + c8) = pq[i];
            *(LAS u32x4*)(VT + s * 136 + c8) = pv[i];
        }
        lds_sync();
        int nit = it + it_stride;
        while (nit < NIT && EC_SKIP(nit)) nit += it_stride;
        const int tb = w >> 1, vb0 = 4 * (w & 1);
        const int tn = tid >> 3, v0 = (tid & 7) * 16; const bool nvalid = c > 0 || tn < 16; const int nrow = c == 0 ? MMAIN + tn : b * SEQ + 64 * (c - 1) + tn;
        f32x4 gnv[4];
#pragma unroll
        for (int i = 0; i < 4; ++i) gnv[i] = *(const f32x4*)(gnorm + v0 + 4 * i);
        u32x4 g0 = {0u, 0u, 0u, 0u}, g1 = {0u, 0u, 0u, 0u};
        if (nvalid) { const bf16_t* gp = P + (size_t)nrow * LDPE + 2560 + 128 * h + v0; g0 = *(const u32x4*)gp; g1 = *(const u32x4*)(gp + 8); }
        const float lbA = h == 0 ? lb6a[0] : (h == 1 ? lb6a[1] : (h == 2 ? lb6a[2] : (h == 3 ? lb6a[3] : (h == 4 ? lb6a[4] : lb6a[5]))));
        const float lbB = h == 0 ? lb6b[0] : (h == 1 ? lb6b[1] : (h == 2 ? lb6b[2] : (h == 3 ? lb6b[3] : (h == 4 ? lb6b[4] : lb6b[5]))));
        {
            float runA = 0.f, runB = 0.f;
#pragma unroll
            for (int q = 0; q < 8; ++q) { const int s = 8 * w + q; const bool valid = c > 0 || s < 16; const unsigned zz = *(const LAS unsigned*)(Z + s * 128 + 2 * lane);
                const float sgA = sigm(lo16(zz)), sgB = sigm(hi16(zz)); const float fA = lbA + (1.0f - lbA) * sgA, fB = lbB + (1.0f - lbB) * sgB;
                runA += valid ? __logf(fA) : 0.f; runB += valid ? __logf(fB) : 0.f;
                *(LAS f32x2v*)(Lb + s * 128 + 2 * lane) = (f32x2v){runA, runB};
                *(LAS unsigned*)(Z + s * 128 + 2 * lane) = pack2(valid ? (1.0f - lbA) * (1.0f - sgA) : 0.f, valid ? (1.0f - lbB) * (1.0f - sgB) : 0.f); }
            *(LAS f32x2v*)(Tot + w * 128 + 2 * lane) = (f32x2v){runA, runB};
        }
        lds_sync();
        {
            f32x2v T[7];
#pragma unroll
            for (int g = 0; g < 7; ++g) T[g] = *(const LAS f32x2v*)(Tot + g * 128 + 2 * lane);
            const f32x2v r1 = T[0] + T[1], r2 = r1 + (T[2] + T[3]), r3 = r2 + (T[4] + T[5]);
            const f32x2v E1 = {__expf(r1[0]), __expf(r1[1])}, E2 = {__expf(r2[0]), __expf(r2[1])}, E3 = {__expf(r3[0]), __expf(r3[1])};
            const f32x2v D12 = {__expf(r2[0] - r1[0]), __expf(r2[1] - r1[1])}, D13 = {__expf(r3[0] - r1[0]), __expf(r3[1] - r1[1])}, D23 = {__expf(r3[0] - r2[0]), __expf(r3[1] - r2[1])};
            const f32x2v one2 = {1.0f, 1.0f};
#pragma unroll
            for (int q = 0; q < 8; ++q) {
                const int s = w + 8 * q; const bool valid = c > 0 || s < 16; constexpr int dummy = 0; (void)dummy;
                const int sub = q >> 1;
                const unsigned kz = *(const LAS unsigned*)(Z + s * 128 + 2 * lane); f32x2v bl = *(const LAS f32x2v*)(Lb + s * 128 + 2 * lane); const unsigned qr = *(const LAS unsigned*)(Qd + s * 136 + 2 * lane);
                if (q & 1) bl += T[q - 1];
                const f32x2v eb = {__expf(bl[0]), __expf(bl[1])}; const f32x2v ieb = {__builtin_amdgcn_rcpf(eb[0]), __builtin_amdgcn_rcpf(eb[1])};
                const f32x2v qv = {valid ? silu(lo16(qr)) : 0.f, valid ? silu(hi16(qr)) : 0.f}; const f32x2v qe = qv * eb; const f32x2v ki = (f32x2v){lo16(kz), hi16(kz)} * ieb;
                const f32x2v Es = sub == 0 ? one2 : (sub == 1 ? E1 : (sub == 2 ? E2 : E3)); const f32x2v qb = qe * Es;
                *(LAS unsigned*)(Qd + s * 136 + 2 * lane) = pack2(qe[0], qe[1]); *(LAS unsigned*)(Qb + s * 136 + 2 * lane) = pack2(qb[0], qb[1]);
                if (sub == 0) { const f32x2v k1 = ki * E1, k2 = ki * E2, k3 = ki * E3;
                    *(LAS unsigned*)(Kd + (0 + s) * 136 + 2 * lane) = pack2(ki[0], ki[1]); *(LAS unsigned*)(Kd + (16 + s) * 136 + 2 * lane) = pack2(k1[0], k1[1]);
                    *(LAS unsigned*)(Kd + (48 + s) * 136 + 2 * lane) = pack2(k2[0], k2[1]); *(LAS unsigned*)(Kd + (96 + s) * 136 + 2 * lane) = pack2(k3[0], k3[1]); }
                else if (sub == 1) { const f32x2v k2 = ki * D12, k3 = ki * D13;
                    *(LAS unsigned*)(Kd + (16 + s) * 136 + 2 * lane) = pack2(ki[0], ki[1]); *(LAS unsigned*)(Kd + (48 + s) * 136 + 2 * lane) = pack2(k2[0], k2[1]); *(LAS unsigned*)(Kd + (96 + s) * 136 + 2 * lane) = pack2(k3[0], k3[1]); }
                else if (sub == 2) { const f32x2v k3 = ki * D23;
                    *(LAS unsigned*)(Kd + (48 + s) * 136 + 2 * lane) = pack2(ki[0], ki[1]); *(LAS unsigned*)(Kd + (96 + s) * 136 + 2 * lane) = pack2(k3[0], k3[1]); }
                else { *(LAS unsigned*)(Kd + (96 + s) * 136 + 2 * lane) = pack2(ki[0], ki[1]); }
            }
        }
        lds_sync();
        bf16x8 sfr[4][4];
        { const bf16_t* st = states + ((size_t)bh * NCH + c) * 16384;
#pragma unroll
          for (int kk = 0; kk < 4; ++kk)
#pragma unroll
              for (int vi = 0; vi < 4; ++vi) { sfr[kk][vi] = (bf16x8){0, 0, 0, 0, 0, 0, 0, 0}; if (c != 0) sfr[kk][vi] = *(const bf16x8*)(st + (16 * (vb0 + vi) + fr) * 128 + 32 * kk + 8 * fq); } }
        if (nit < NIT) EC_LOAD(nit)
        for (int bi = w; bi < 10; bi += 8) {
            const int i = bi >= 6 ? 3 : (bi >= 3 ? 2 : (bi >= 1 ? 1 : 0)); const int j = bi - (i * (i + 1)) / 2; const int offi = i == 0 ? 0 : (i == 1 ? 16 : (i == 2 ? 48 : 96));
            f32x4 acc = {0.f, 0.f, 0.f, 0.f};
#pragma unroll
            for (int kk = 0; kk < 4; ++kk) { const bf16x8 a = *(const LAS bf16x8*)(Qd + (16 * i + fr) * 136 + 32 * kk + 8 * fq); const bf16x8 bb = *(const LAS bf16x8*)(Kd + (offi + 16 * j + fr) * 136 + 32 * kk + 8 * fq); acc = mfma16(a, bb, acc); }
#pragma unroll
            for (int e = 0; e < 4; ++e) { const float v = (j == i && fr > 4 * fq + e) ? 0.f : acc[e]; Am[(16 * i + 4 * fq + e) * 72 + 16 * j + fr] = (bf16_t)f2bf(v); }
        }
        if (w >= 2) { const int zb = w - 2; const int zi = zb < 3 ? 0 : (zb < 5 ? 1 : 2); const int zj = zb < 3 ? zb + 1 : (zb < 5 ? zb - 1 : 3);
#pragma unroll
            for (int e = 0; e < 4; ++e) Am[(16 * zi + 4 * fq + e) * 72 + 16 * zj + fr] = (bf16_t)0; }
        lds_sync();
        {
            f32x4 acc[4];
#pragma unroll
            for (int vi = 0; vi < 4; ++vi) acc[vi] = (f32x4){0.f, 0.f, 0.f, 0.f};
#pragma unroll
            for (int kk = 0; kk < 4; ++kk) { const bf16x8 a = *(const LAS bf16x8*)(Qb + (16 * tb + fr) * 136 + 32 * kk + 8 * fq);
#pragma unroll
                for (int vi = 0; vi < 4; ++vi) acc[vi] = mfma16(a, sfr[kk][vi], acc[vi]); }
#pragma unroll
            for (int kk = 0; kk < 2; ++kk) { const bf16x8 a = *(const LAS bf16x8*)(Am + (16 * tb + fr) * 72 + 32 * kk + 8 * fq);
#pragma unroll
                for (int vi = 0; vi < 4; ++vi) { const bf16x8 bb = tr_frag(VT, 32 * kk, 16 * (vb0 + vi), fr, fq); acc[vi] = mfma16(a, bb, acc[vi]); } }
#pragma unroll
            for (int vi = 0; vi < 4; ++vi)
#pragma unroll
                for (int e = 0; e < 4; ++e) O[(16 * tb + 4 * fq + e) * 132 + 16 * (vb0 + vi) + fr] = acc[vi][e];
        }
        lds_sync();
        {
            f32x4 o[4]; float ss = 0.f;
#pragma unroll
            for (int i = 0; i < 4; ++i) { o[i] = *(const LAS f32x4*)(O + tn * 132 + v0 + 4 * i); ss += (o[i][0] * o[i][0] + o[i][1] * o[i][1]) + (o[i][2] * o[i][2] + o[i][3] * o[i][3]); }
            ss += __shfl_xor(ss, 1); ss += __shfl_xor(ss, 2); ss += __shfl_xor(ss, 4);
            const float rn = rsqrtf(ss * (1.0f / 128.0f) + EPS);
            if (nvalid) {
                const unsigned gw[8] = {g0.x, g0.y, g0.z, g0.w, g1.x, g1.y, g1.z, g1.w}; unsigned ow[8];
#pragma unroll
                for (int i = 0; i < 4; ++i) { const f32x4 gn = gnv[i];
                    const float y0 = o[i][0] * rn * gn[0] * silu(lo16(gw[2 * i])), y1 = o[i][1] * rn * gn[1] * silu(hi16(gw[2 * i])), y2 = o[i][2] * rn * gn[2] * silu(lo16(gw[2 * i + 1])), y3 = o[i][3] * rn * gn[3] * silu(hi16(gw[2 * i + 1]));
                    ow[2 * i] = pack2(y0, y1); ow[2 * i + 1] = pack2(y2, y3); }
                bf16_t* yp = Y + (size_t)nrow * DM + 256 + 128 * h + v0;
                *(u32x4*)yp = (u32x4){ow[0], ow[1], ow[2], ow[3]}; *(u32x4*)(yp + 8) = (u32x4){ow[4], ow[5], ow[6], ow[7]};
            }
        }
        lds_sync();
        it = nit;
    }
#undef EC_LOAD
#undef EC_SKIP
}

__device__ __forceinline__ void pool_items(const float* pw, const float* pscale, const bf16_t* P, bf16_t* Y, ldsp_t lds, int it_first, int it_stride, int it_end) {
    LAS float* U = (LAS float*)lds;
    LAS float* Wp = (LAS float*)(lds + 20224);
    LAS float* Mx = (LAS float*)(lds + 36608);
    const int tid = opaque_tid();
    const int NIT = it_end;
    u32x4 pv[2];
#define POOL_LOAD(IT) { const int g_ = (IT) & 3, bc_ = (IT) >> 2; const int b_ = bc_ == 512 ? 0 : bc_ >> 6, c_ = bc_ == 512 ? 0 : (bc_ & 63) + 1; \
        const int t0_ = c_ == 0 ? 0 : 16 + 64 * (c_ - 1), ntok_ = c_ == 0 ? 16 : 64; \
        _Pragma("unroll") for (int k = 0; k < 2; ++k) { const int idx = tid + 512 * k; const int r = idx >> 3, c8 = (idx & 7) * 8, ta = t0_ - 15 + r; pv[k] = (u32x4){0u, 0u, 0u, 0u}; \
            if (idx < 79 * 8 && ta >= 0 && r < 15 + ntok_) pv[k] = *(const u32x4*)(P + (size_t)row_of(b_, ta) * LDPE + 64 * g_ + c8); } }
    int it = it_first, cur_g = -1; f32x4 ps0 = {0.f, 0.f, 0.f, 0.f}, ps1 = {0.f, 0.f, 0.f, 0.f};
    if (it < NIT) POOL_LOAD(it)
    while (it < NIT) {
        const int g = it & 3, bc = it >> 2; const int b = bc == 512 ? 0 : bc >> 6, c = bc == 512 ? 0 : (bc & 63) + 1;
        const int t0 = c == 0 ? 0 : 16 + 64 * (c - 1), ntok = c == 0 ? 16 : 64, wsz = 2 << g;
#pragma unroll
        for (int k = 0; k < 2; ++k) { const int idx = tid + 512 * k; if (idx < 79 * 8) { const int r = idx >> 3, c8 = (idx & 7) * 8; const u32x4 v = pv[k];
            LAS float* up = U + r * 64 + c8; up[0] = lo16(v.x); up[1] = hi16(v.x); up[2] = lo16(v.y); up[3] = hi16(v.y); up[4] = lo16(v.z); up[5] = hi16(v.z); up[6] = lo16(v.w); up[7] = hi16(v.w); } }
        if (g != cur_g) { cur_g = g; ps0 = *(const f32x4*)(pscale + 64 * g + (tid & 7) * 8); ps1 = *(const f32x4*)(pscale + 64 * g + (tid & 7) * 8 + 4);
#pragma unroll
            for (int i = 0; i < 8; ++i) Wp[tid + 512 * i] = pw[g * 4096 + tid + 512 * i]; }
        lds_sync();
        const int nit = it + it_stride;
        if (nit < NIT) POOL_LOAD(nit)
#pragma unroll
        for (int i = 0; i < 8; ++i) { const int idx = tid + 512 * i, s = idx >> 6, ch = idx & 63, ta = t0 + s; float sum = 0.f;
            for (int j = 0; j < wsz; ++j) sum += U[(s + 15 - j) * 64 + ch];
            const int cnt = (ta + 1) < wsz ? (ta + 1) : wsz; Mx[s * 65 + ch] = sum * __builtin_amdgcn_rcpf((float)cnt) - U[(s + 15) * 64 + ch]; }
        lds_sync();
        { const int s = tid >> 3, d0 = (tid & 7) * 8; f32x4 a0 = {0.f, 0.f, 0.f, 0.f}, a1 = {0.f, 0.f, 0.f, 0.f};
          for (int ch = 0; ch < 64; ++ch) { const float m = Mx[s * 65 + ch]; a0 += m * *(const LAS f32x4*)(Wp + ch * 64 + d0); a1 += m * *(const LAS f32x4*)(Wp + ch * 64 + d0 + 4); }
          if (s < ntok) { a0 *= ps0; a1 *= ps1;
              u32x4 o; o.x = pack2(a0[0], a0[1]); o.y = pack2(a0[2], a0[3]); o.z = pack2(a1[0], a1[1]); o.w = pack2(a1[2], a1[3]);
              *(u32x4*)(Y + (size_t)row_of(b, t0 + s) * DM + 64 * g + d0) = o; } }
        lds_sync();
        it = nit;
    }
#undef POOL_LOAD
}

#undef CVG
#define CVG 3
__device__ void conv_items(const Params& p, const bf16_t* P, bf16_t* Y, ldsp_t lds) {
    LAS float* U = (LAS float*)lds;
    LAS float* Wc = (LAS float*)(lds + 48128);
    LAS float* Cv = (LAS float*)(lds + 64000);
    const int tid = opaque_tid(); const float* cw = p.in[18]; const float* cb = p.in[19]; const float* lg = p.in[20]; const float* lbb = p.in[21];
    const int NIT = 513 * 4;
    u32x4 pa[3], pb[3];
#define CONV_LOAD(IT) { const int g_ = (IT) & 3, bc_ = (IT) >> 2; const int b_ = bc_ == 512 ? 0 : bc_ >> 6, c_ = bc_ == 512 ? 0 : (bc_ & 63) + 1; \
        const int t0_ = c_ == 0 ? 0 : 16 + 64 * (c_ - 1), ntok_ = c_ == 0 ? 16 : 64; \
        _Pragma("unroll") for (int k = 0; k < 3; ++k) { const int idx = tid + 512 * k; const int r = idx >> 4, c8 = (idx & 15) * 8, ta = t0_ - 30 + r; pa[k] = (u32x4){0u, 0u, 0u, 0u}; pb[k] = (u32x4){0u, 0u, 0u, 0u}; \
            if (idx < 94 * 16 && ta >= 0 && r < 30 + ntok_) { const bf16_t* pr = P + (size_t)row_of(b_, ta) * LDPO + 128 * g_ + c8; pa[k] = *(const u32x4*)pr; pb[k] = *(const u32x4*)(pr + 512); } } }
    int it = blockIdx.x, cur_g = -1; float cbias = 0.f; f32x4 lgv[4], lbv[4];
#pragma unroll
    for (int i = 0; i < 4; ++i) { lgv[i] = (f32x4){0.f, 0.f, 0.f, 0.f}; lbv[i] = (f32x4){0.f, 0.f, 0.f, 0.f}; }
    if (it < NIT) CONV_LOAD(it)
    while (it < NIT) {
        const int g = it & 3, bc = it >> 2; const int b = bc == 512 ? 0 : bc >> 6, c = bc == 512 ? 0 : (bc & 63) + 1;
        const int t0 = c == 0 ? 0 : 16 + 64 * (c - 1), ntok = c == 0 ? 16 : 64;
#pragma unroll
        for (int k = 0; k < 3; ++k) { const int idx = tid + 512 * k; if (idx < 94 * 16) { const int r = idx >> 4, c8 = (idx & 15) * 8; const u32x4 av = pa[k], bv = pb[k];
            LAS float* up = U + r * 128 + c8;
            up[0] = lo16(av.x) * sigm(lo16(bv.x)); up[1] = hi16(av.x) * sigm(hi16(bv.x)); up[2] = lo16(av.y) * sigm(lo16(bv.y)); up[3] = hi16(av.y) * sigm(hi16(bv.y));
            up[4] = lo16(av.z) * sigm(lo16(bv.z)); up[5] = hi16(av.z) * sigm(hi16(bv.z)); up[6] = lo16(av.w) * sigm(lo16(bv.w)); up[7] = hi16(av.w) * sigm(hi16(bv.w)); } }
        if (g != cur_g) { cur_g = g; for (int idx = tid; idx < 31 * 128; idx += 512) Wc[idx] = cw[(idx >> 7) * 512 + 128 * g + (idx & 127)];
            cbias = cb[128 * g + (tid & 127)];
#pragma unroll
            for (int i = 0; i < 4; ++i) { lgv[i] = *(const f32x4*)(lg + 128 * g + (tid & 7) * 16 + 4 * i); lbv[i] = *(const f32x4*)(lbb + 128 * g + (tid & 7) * 16 + 4 * i); } }
        lds_sync();
        const int nit = it + (int)gridDim.x;
        if (nit < NIT) CONV_LOAD(nit)
        { const int ch = tid & 127, sb = tid >> 7; const float bias = cbias;
          float wr[31];
#pragma unroll
          for (int j = 0; j < 31; ++j) wr[j] = Wc[j * 128 + ch];
          float acc[16];
#pragma unroll
          for (int q = 0; q < 16; ++q) acc[q] = bias;
#pragma unroll
          for (int r = 0; r < 46; ++r) { const float uv = U[(16 * sb + r) * 128 + ch];
#pragma unroll
              for (int q = 0; q < 16; ++q) if (r - q >= 0 && r - q < 31) acc[q] += wr[r - q] * uv; }
#pragma unroll
          for (int q = 0; q < 16; ++q) Cv[(16 * sb + q) * 128 + ch] = acc[q]; }
        lds_sync();
        { const int t = tid >> 3, c0 = (tid & 7) * 16; f32x4 v[4]; float sm = 0.f;
#pragma unroll
          for (int i = 0; i < 4; ++i) { v[i] = *(const LAS f32x4*)(Cv + t * 128 + c0 + 4 * i); sm += (v[i][0] + v[i][1]) + (v[i][2] + v[i][3]); }
          sm += __shfl_xor(sm, 1); sm += __shfl_xor(sm, 2); sm += __shfl_xor(sm, 4);
          const float mu = sm * (1.0f / 128.0f); float sq = 0.f;
#pragma unroll
          for (int i = 0; i < 4; ++i) { v[i] -= mu; sq += (v[i][0] * v[i][0] + v[i][1] * v[i][1]) + (v[i][2] * v[i][2] + v[i][3] * v[i][3]); }
          sq += __shfl_xor(sq, 1); sq += __shfl_xor(sq, 2); sq += __shfl_xor(sq, 4);
          const float rs = rsqrtf(sq * (1.0f / 128.0f) + EPS);
          if (t < ntok) { unsigned ow[8];
#pragma unroll
              for (int i = 0; i < 4; ++i) { const f32x4 un = v[i] * rs * lgv[i] + lbv[i];
                  ow[2 * i] = pack2(silu(un[0]), silu(un[1])); ow[2 * i + 1] = pack2(silu(un[2]), silu(un[3])); }
              bf16_t* yp = Y + (size_t)row_of(b, t0 + t) * DM + 128 * g + c0;
              *(u32x4*)yp = (u32x4){ow[0], ow[1], ow[2], ow[3]}; *(u32x4*)(yp + 8) = (u32x4){ow[4], ow[5], ow[6], ow[7]}; } }
        lds_sync();
        it = nit;
    }
#undef CONV_LOAD
}

__device__ void lru_items(const Params& p, const bf16_t* P, float* hloc, float* cpo, float* aagg, float* bagg, ldsp_t lds) {
    LAS float* XB = (LAS float*)lds;
    LAS float* Uc = (LAS float*)(lds + 17152);
    LAS bf16_t* Ub = (LAS bf16_t*)(lds + 33536);
    LAS bf16_t* WaT = (LAS bf16_t*)(lds + 42752);
    LAS bf16_t* WxT = (LAS bf16_t*)(lds + 51968);
    LAS float* Aa = (LAS float*)(lds + 61184);
    LAS float* Bt = (LAS float*)(lds + 77568);
    LAS float* Ag = (LAS float*)(lds + 93952);
    LAS float* Bg = (LAS float*)(lds + 96000);
    const int tid = opaque_tid(), lane = tid & 63, w = tid >> 6, fr = lane & 15, fq = lane >> 4;
    const float* cw = p.in[22]; const float* cb = p.in[23]; const float* wa = p.in[24]; const float* ba = p.in[25]; const float* wx = p.in[26]; const float* bx = p.in[27]; const float* lam = p.in[28];
    int cur_hh = -1; float lcb = 0.f, lcw[4] = {0.f, 0.f, 0.f, 0.f}, lba[2] = {0.f, 0.f}, lbx[2] = {0.f, 0.f}, lsp[2] = {0.f, 0.f};
    const int NIT = 8 * NCH * 8;
    u32x4 px[2];
#define LRU_LOAD(IT) { const int hh_ = (IT) & 7, bc_ = (IT) >> 3, b_ = bc_ / NCH, c_ = bc_ % NCH; const int t0_ = c_ == 0 ? 0 : 16 + 64 * (c_ - 1), ntok_ = c_ == 0 ? 16 : 64; \
        _Pragma("unroll") for (int k = 0; k < 2; ++k) { const int idx = tid + 512 * k; const int r = idx >> 3, c8 = (idx & 7) * 8, ta = t0_ - 3 + r; px[k] = (u32x4){0u, 0u, 0u, 0u}; \
            if (idx < 67 * 8 && ta >= 0 && r < 3 + ntok_) px[k] = *(const u32x4*)(P + (size_t)row_of(b_, ta) * LDPO + 1024 + 64 * hh_ + c8); } }
    int it = blockIdx.x;
    if (it < NIT) LRU_LOAD(it)
    while (it < NIT) {
        const int hh = it & 7, bc = it >> 3, b = bc / NCH, c = bc % NCH;
        const int t0 = c == 0 ? 0 : 16 + 64 * (c - 1), ntok = c == 0 ? 16 : 64;
#pragma unroll
        for (int k = 0; k < 2; ++k) { const int idx = tid + 512 * k; if (idx < 67 * 8) { const int r = idx >> 3, c8 = (idx & 7) * 8; const u32x4 v = px[k];
            LAS float* up = XB + r * 64 + c8; up[0] = lo16(v.x); up[1] = hi16(v.x); up[2] = lo16(v.y); up[3] = hi16(v.y); up[4] = lo16(v.z); up[5] = hi16(v.z); up[6] = lo16(v.w); up[7] = hi16(v.w); } }
        if (hh != cur_hh) {
            cur_hh = hh;
            { const int chq = tid & 63; lcb = cb[64 * hh + chq];
#pragma unroll
              for (int j = 0; j < 4; ++j) lcw[j] = cw[j * 512 + 64 * hh + chq];
#pragma unroll
              for (int j = 0; j < 2; ++j) { const int o = 16 * (2 * (w & 1) + j) + fr; lba[j] = ba[64 * hh + o]; lbx[j] = bx[64 * hh + o]; lsp[j] = log1pf(__expf(-lam[64 * hh + o])); } }
#pragma unroll
            for (int i = 0; i < 8; ++i) { const int idx = tid + 512 * i, ii = idx >> 6, o = idx & 63; WaT[o * 72 + ii] = (bf16_t)f2bf(wa[hh * 4096 + idx]); WxT[o * 72 + ii] = (bf16_t)f2bf(wx[hh * 4096 + idx]); }
        }
        lds_sync();
        const int nit = it + (int)gridDim.x;
        if (nit < NIT) LRU_LOAD(nit)
#pragma unroll
        for (int i = 0; i < 8; ++i) { const int idx = tid + 512 * i, s = idx >> 6, ch = idx & 63; float u = lcb;
#pragma unroll
            for (int j = 0; j < 4; ++j) u += lcw[j] * XB[(s + j) * 64 + ch];
            Uc[idx] = u; Ub[s * 72 + ch] = (bf16_t)f2bf(u); }
        lds_sync();
        {
            const int sbk = w >> 1, ob0 = 2 * (w & 1);
            f32x4 accA[2], accX[2];
#pragma unroll
            for (int j = 0; j < 2; ++j) { accA[j] = (f32x4){0.f, 0.f, 0.f, 0.f}; accX[j] = (f32x4){0.f, 0.f, 0.f, 0.f}; }
#pragma unroll
            for (int kk = 0; kk < 2; ++kk) { const bf16x8 a = *(const LAS bf16x8*)(Ub + (16 * sbk + fr) * 72 + 32 * kk + 8 * fq);
#pragma unroll
                for (int j = 0; j < 2; ++j) { const bf16x8 b1 = *(const LAS bf16x8*)(WaT + (16 * (ob0 + j) + fr) * 72 + 32 * kk + 8 * fq), b2 = *(const LAS bf16x8*)(WxT + (16 * (ob0 + j) + fr) * 72 + 32 * kk + 8 * fq);
                    accA[j] = mfma16(a, b1, accA[j]); accX[j] = mfma16(a, b2, accX[j]); } }
#pragma unroll
            for (int j = 0; j < 2; ++j) { const int o = 16 * (ob0 + j) + fr; const float bao = lba[j], bxo = lbx[j]; const float sp = lsp[j];
#pragma unroll
                for (int e = 0; e < 4; ++e) { const int s = 16 * sbk + 4 * fq + e; const bool valid = s < ntok; const bool first = (t0 + s) == 0;
                    const float rr = sigm(accA[j][e] + bao), ig = sigm(accX[j][e] + bxo); const float la = -8.0f * rr * sp; const float a = __expf(la); const float x2 = 2.0f * la; const float m2 = x2 > -0.05f ? -x2 * (1.0f + x2 * (0.5f + x2 * (0.16666667f + x2 * 0.041666668f))) : 1.0f - a * a; const float mult = __builtin_amdgcn_sqrtf(m2);
                    const float bt = (first ? 1.0f : mult) * ig * Uc[s * 64 + o];
                    Aa[s * 64 + o] = valid ? a : 1.0f; Bt[s * 64 + o] = valid ? bt : 0.f; } }
        }
        lds_sync();
        const int ch = tid & 63, sb = tid >> 6;
        { float cp = 1.0f, hv = 0.f;
#pragma unroll
          for (int q = 0; q < 8; ++q) { const int s = 8 * sb + q; const float a = Aa[s * 64 + ch], bt = Bt[s * 64 + ch]; hv = a * hv + bt; cp *= a; Aa[s * 64 + ch] = cp; Bt[s * 64 + ch] = hv; }
          Ag[sb * 64 + ch] = cp; Bg[sb * 64 + ch] = hv; }
        lds_sync();
        { float carry = 0.f, cpin = 1.0f;
          for (int q = 0; q < sb; ++q) { const float a = Ag[q * 64 + ch]; carry = a * carry + Bg[q * 64 + ch]; cpin *= a; }
          float hl = 0.f, cf = 1.0f;
#pragma unroll
          for (int q = 0; q < 8; ++q) { const int s = 8 * sb + q; hl = Bt[s * 64 + ch] + Aa[s * 64 + ch] * carry; cf = Aa[s * 64 + ch] * cpin;
              if (s < ntok && (c > 0 || b == 0)) { const size_t o = (size_t)row_of(b, t0 + s) * 512 + 64 * hh + ch; hloc[o] = hl; cpo[o] = cf; } }
          if (sb == 7) { aagg[((size_t)b * NCH + c) * 512 + 64 * hh + ch] = cf; bagg[((size_t)b * NCH + c) * 512 + 64 * hh + ch] = hl; } }
        lds_sync();
        it = nit;
    }
#undef LRU_LOAD
}

__device__ void lru_combine(const bf16_t* P, const float* hloc, const float* cpo, const float* aagg, const float* bagg, bf16_t* Y, ldsp_t lds) {
    LAS float* Cr = (LAS float*)lds;
    const int tid = opaque_tid(), lane = tid & 63, w = tid >> 6;
    for (int bc = blockIdx.x; bc < 513; bc += gridDim.x) {
        const int b = bc == 512 ? 0 : bc >> 6, c = bc == 512 ? 0 : (bc & 63) + 1;
        const int t0 = c == 0 ? 0 : 16 + 64 * (c - 1), ntok = c == 0 ? 16 : 64;
        { float carry = 0.f; const float* ap = aagg + (size_t)b * NCH * 512 + tid; const float* bp = bagg + (size_t)b * NCH * 512 + tid;
          int q = 0;
          for (; q + 8 <= c; q += 8) { float a[8], bb[8];
#pragma unroll
              for (int j = 0; j < 8; ++j) { a[j] = ap[(q + j) * 512]; bb[j] = bp[(q + j) * 512]; }
#pragma unroll
              for (int j = 0; j < 8; ++j) carry = a[j] * carry + bb[j]; }
          for (; q < c; ++q) carry = ap[q * 512] * carry + bp[q * 512];
          Cr[tid] = carry; }
        lds_sync();
        const f32x4 c0 = *(const LAS f32x4*)(Cr + lane * 8), c1 = *(const LAS f32x4*)(Cr + lane * 8 + 4);
        for (int s0 = w; s0 < ntok; s0 += 32) {
            f32x4 h0[4], h1[4], p0[4], p1[4]; u32x4 g[4];
#pragma unroll
            for (int k = 0; k < 4; ++k) { const int s = s0 + 8 * k; if (s < ntok) { const size_t row = (size_t)row_of(b, t0 + s);
                h0[k] = *(const f32x4*)(hloc + row * 512 + lane * 8); h1[k] = *(const f32x4*)(hloc + row * 512 + lane * 8 + 4);
                p0[k] = *(const f32x4*)(cpo + row * 512 + lane * 8); p1[k] = *(const f32x4*)(cpo + row * 512 + lane * 8 + 4);
                g[k] = *(const u32x4*)(P + row * LDPO + 1536 + lane * 8); } }
            asm volatile("" ::: "memory");
#pragma unroll
            for (int k = 0; k < 4; ++k) { const int s = s0 + 8 * k; if (s < ntok) { const size_t row = (size_t)row_of(b, t0 + s);
                const f32x4 v0 = h0[k] + p0[k] * c0, v1 = h1[k] + p1[k] * c1; u32x4 o;
                o.x = pack2(gelu_tanh(lo16(g[k].x)) * v0[0], gelu_tanh(hi16(g[k].x)) * v0[1]); o.y = pack2(gelu_tanh(lo16(g[k].y)) * v0[2], gelu_tanh(hi16(g[k].y)) * v0[3]);
                o.z = pack2(gelu_tanh(lo16(g[k].z)) * v1[0], gelu_tanh(hi16(g[k].z)) * v1[1]); o.w = pack2(gelu_tanh(lo16(g[k].w)) * v1[2], gelu_tanh(hi16(g[k].w)) * v1[3]);
                *(u32x4*)(Y + row * DM + 512 + lane * 8) = o; } }
        }
        lds_sync();
    }
}

__device__ void final_norm(float* H, const float* __restrict__ fn) {
    const int tid_ = opaque_tid(); const int lane = tid_ & 63, gw = blockIdx.x * 8 + (tid_ >> 6), nw = gridDim.x * 8;
    f32x4 g[4];
#pragma unroll
    for (int i = 0; i < 4; ++i) g[i] = *(const f32x4*)(fn + i * 256 + lane * 4);
    f32x4 v[4], nv[4];
    int row = gw;
    if (row < MMAIN) {
#pragma unroll
        for (int i = 0; i < 4; ++i) v[i] = *(const f32x4*)(H + (size_t)row * DM + i * 256 + lane * 4); }
    while (row < MMAIN) {
        const int nrow = row + nw;
        if (nrow < MMAIN) {
#pragma unroll
            for (int i = 0; i < 4; ++i) nv[i] = *(const f32x4*)(H + (size_t)nrow * DM + i * 256 + lane * 4); }
        asm volatile("" ::: "memory");
        float ss = 0.f;
#pragma unroll
        for (int i = 0; i < 4; ++i) ss += (v[i][0] * v[i][0] + v[i][1] * v[i][1]) + (v[i][2] * v[i][2] + v[i][3] * v[i][3]);
#pragma unroll
        for (int o = 32; o >= 1; o >>= 1) ss += __shfl_xor(ss, o);
        const float rs = rsqrtf(ss * (1.0f / 1024.0f) + EPS);
#pragma unroll
        for (int i = 0; i < 4; ++i) *(f32x4*)(H + (size_t)row * DM + i * 256 + lane * 4) = v[i] * rs * g[i];
#pragma unroll
        for (int i = 0; i < 4; ++i) v[i] = nv[i];
        row = nrow;
    }
}

#define XB_TMO      128
#define XB_XCNT(j)  (256  + 64 * (j))
#define XB_XSUB(j)  (1280 + 64 * (j))
#define XB_XGEN(j)  (2304 + 64 * (j))
#define XB_TOP      3328
#define XB_TOPGEN   3392
#define XCD_BAR_WORDS 3456
#define XB_SPIN_CAP (1u << 18)

__device__ __forceinline__ unsigned xb_ld(unsigned* p)              { return __hip_atomic_load(p, __ATOMIC_RELAXED, __HIP_MEMORY_SCOPE_AGENT); }
__device__ __forceinline__ unsigned xb_add(unsigned* p, unsigned v) { return __hip_atomic_fetch_add(p, v, __ATOMIC_RELAXED, __HIP_MEMORY_SCOPE_AGENT); }
__device__ __forceinline__ unsigned xb_xcc_id() { return (unsigned)__builtin_amdgcn_s_getreg((3 << 11) | 20) & 0xFu; }
#define XB_SPIN(cond, bar) do { unsigned _sp = 0; while (cond) { __builtin_amdgcn_s_sleep(1); \
    if ((++_sp & 255u) == 0u) { if (xb_ld(&(bar)[XB_TMO])) break; if (_sp > XB_SPIN_CAP) { atomicAdd(&(bar)[XB_TMO], 1u); break; } } } } while (0)

struct XcdBarrier {
    unsigned* bar; unsigned x;
    volatile LAS unsigned* st;
};

__device__ __forceinline__ XcdBarrier xcd_barrier_post(unsigned* bar, volatile LAS unsigned* st) {
    XcdBarrier b; b.bar = bar; b.x = xb_xcc_id(); b.st = st;
    if (threadIdx.x == 0) { const unsigned slot = xb_add(&bar[XB_XCNT(b.x)], 1u); st[2] = slot * 8u + b.x; }
    return b;
}
__device__ __forceinline__ void xcd_barrier_complete(unsigned* bar, unsigned x, unsigned& nloc, unsigned& nx) {
    const unsigned G = gridDim.x * gridDim.y * gridDim.z;
    unsigned sum, cnt, mine, sp = 0u;
    for (;;) {
        sum = 0u; cnt = 0u; mine = 0u;
#pragma unroll
        for (unsigned j = 0; j < 16; ++j) { const unsigned c = xb_ld(&bar[XB_XCNT(j)]); sum += c; cnt += (c > 0u) ? 1u : 0u; mine = (j == x) ? c : mine; }
        if (sum == G) break;
        __builtin_amdgcn_s_sleep(1);
        if ((++sp & 255u) == 0u) { if (xb_ld(&bar[XB_TMO])) break; if (sp > XB_SPIN_CAP) { atomicAdd(&bar[XB_TMO], 1u); break; } }
    }
    nloc = mine > 0u ? mine : 1u; nx = cnt > 0u ? cnt : 1u;
}

__device__ __noinline__ void xcd_barrier(const XcdBarrier b) {
    asm volatile("s_waitcnt vmcnt(0)" ::: "memory");
    __syncthreads();
    if (threadIdx.x == 0) {
        unsigned* bar = b.bar;
        __builtin_amdgcn_s_waitcnt(0);
        unsigned nloc = b.st[0], nx = b.st[1];
        if (nloc == 0u) { xcd_barrier_complete(bar, b.x, nloc, nx); b.st[0] = nloc; b.st[1] = nx; }
        const unsigned old = xb_add(&bar[XB_XSUB(b.x)], 1u);
        const unsigned gen = old / nloc;
        if (old + 1u == (gen + 1u) * nloc) {
            __builtin_amdgcn_fence(__ATOMIC_RELEASE, "agent");
            asm volatile("s_waitcnt vmcnt(0)" ::: "memory");
            const unsigned og = xb_add(&bar[XB_TOP], 1u);
            const unsigned tg = og / nx;
            if (og + 1u == (tg + 1u) * nx) xb_add(&bar[XB_TOPGEN], 1u);
            else XB_SPIN(xb_ld(&bar[XB_TOPGEN]) == tg, bar);
            __builtin_amdgcn_fence(__ATOMIC_ACQUIRE, "agent");
            xb_add(&bar[XB_XGEN(b.x)], 1u);
            asm volatile("s_waitcnt vmcnt(0)" ::: "memory");
        } else {
            XB_SPIN(xb_ld(&bar[XB_XGEN(b.x)]) == gen, bar);
            __builtin_amdgcn_fence(__ATOMIC_ACQUIRE, "agent");
            asm volatile("s_waitcnt vmcnt(0)" ::: "memory");
        }
    }
    __syncthreads();
}


#ifdef PROBE_GEMM_L2
struct NullEpi { static constexpr bool PERM = false, AFTER_DRAIN = false; float* sink;
    __device__ __forceinline__ void operator()(const f32x4 (&acc)[2][2][4][2], const pg8::Unit& u, int wr, int wc, int fr, int fq, int, ldsp_t) const {
        float s = 0.f;
#pragma unroll
        for (int ai = 0; ai < 2; ++ai)
#pragma unroll
            for (int bj = 0; bj < 2; ++bj)
#pragma unroll
                for (int m = 0; m < 4; ++m)
#pragma unroll
                    for (int n = 0; n < 2; ++n) s += acc[ai][bj][m][n][0] + acc[ai][bj][m][n][1] + acc[ai][bj][m][n][2] + acc[ai][bj][m][n][3];
        if (s == 123.456f) sink[0] = s; } };
struct ProbeOrder : pg8::StaticOrder { __device__ bool next(int i, pg8::Unit& u) const { const bool ok = pg8::StaticOrder::next(i, u); u.pm = 0; u.pn = 0; return ok; } };
#endif
__device__ __noinline__ void rstd_table(ldsp_t lds, int N, int vcu, const float* rowss) {
    pg8::StaticOrder S; S.init(MMAIN, N, (int)gridDim.x, vcu);
    LAS float* tab = (LAS float*)(lds + RSTD_TAB_OFF);
    const int tid = opaque_tid(); pg8::Unit u;
    for (int i0 = 0; i0 < 12; i0 += 2) { const int i = i0 + (tid >> 8);
        if (S.next(i, u)) { const float* rp = rowss + (size_t)(u.pm * 256 + (tid & 255)) * 16;
            const f32x4 a = *(const f32x4*)rp, b = *(const f32x4*)(rp + 4), c = *(const f32x4*)(rp + 8), d = *(const f32x4*)(rp + 12);
            const f32x4 s4 = (a + b) + (c + d); tab[i * 256 + (tid & 255)] = rsqrtf(((s4[0] + s4[1]) + (s4[2] + s4[3])) * (1.0f / 1024.0f) + EPS); } }
    __syncthreads();
}
template <class Epi> __device__ __forceinline__ void run_gemm(ldsp_t lds, const bf16_t* A, const bf16_t* Bt, int N, int K, const Epi& E, int vcu) {
    pg8::Gemm g{A, Bt, MMAIN, N, K}; pg8::StaticOrder S; S.init(MMAIN, N, (int)gridDim.x, vcu);
    pg8::gemm_phase<Epi, pg8::StaticOrder>(lds, g, S, E);
}

__global__ void __launch_bounds__(512, 2) fwd_megakernel(Params p) {
    extern __shared__ __attribute__((aligned(16))) unsigned char lds_raw[];
    cg::grid_group grid = cg::this_grid();
    ldsp_t lds = (ldsp_t)lds_raw;
    unsigned char* ws = p.ws;
    volatile LAS unsigned* xst = (volatile LAS unsigned*)(lds + 155136);
    if (threadIdx.x < 4) xst[threadIdx.x] = 0u;
    __syncthreads();
    XcdBarrier xb = xcd_barrier_post((unsigned*)(ws + OFF_BAR), xst);
    bf16_t* X1 = (bf16_t*)(ws + OFF_X1); bf16_t* Y = (bf16_t*)(ws + OFF_Y); bf16_t* BIG = (bf16_t*)(ws + OFF_BIG); unsigned char* R = ws + OFF_R;
    float* hmeta = (float*)(ws + OFF_HMETA); float* rowss = (float*)(ws + OFF_ROWSS); float* dec = (float*)(ws + OFF_DEC); float* aagg = (float*)(ws + OFF_AAGG); float* bagg = (float*)(ws + OFF_BAGG);
#ifndef REP_UP
#define REP_UP 1
#endif
#ifndef REP_DOWN
#define REP_DOWN 0
#endif
#ifndef REP_SYNC
#define REP_SYNC 1
#endif
#if REP_SYNC > 1
#define GSYNC() { xcd_barrier(xb); xcd_barrier(xb); }
#else
#define GSYNC() { xcd_barrier(xb); }
#endif
#define GEMM_UP1(WOFF) { meta_gemm<0, 4>(lds, X1 + (size_t)MMAIN * DM, (const bf16_t*)(WOFF), 176, hmeta, BIG, DFF, 0.f); rstd_table(lds, 5632, vcu, rowss); EpiUp eu{BIG, rowss}; run_gemm<EpiUp>(lds, X1, (const bf16_t*)(WOFF), 5632, DM, eu, vcu); }
#if REP_UP > 1
#define GEMM_UP(WOFF) GEMM_UP1(WOFF) GEMM_UP1(WOFF) GSYNC();
#else
#define GEMM_UP(WOFF) GEMM_UP1(WOFF) GSYNC();
#endif
#if REP_DOWN > 0
#define GEMM_DOWN2(WOFF) { EpiRes e2{p.out, p.out, X1, rowss, 0.0f}; run_gemm<EpiRes>(lds, BIG, (const bf16_t*)(WOFF), DM, DFF, e2, vcu); }
#else
#define GEMM_DOWN2(WOFF)
#endif
#define GEMM_DOWN(WOFF, BASEMAIN) { meta_gemm<2, 11>(lds, BIG + (size_t)MMAIN * DFF, (const bf16_t*)(WOFF), 64, hmeta, X1, DM, 0.5f); EpiRes er{BASEMAIN, p.out, X1, rowss, 0.5f}; run_gemm<EpiRes>(lds, BIG, (const bf16_t*)(WOFF), DM, DFF, er, vcu); } GEMM_DOWN2(WOFF) GSYNC();
#define GEMM_OUT(WOFF) { meta_gemm<2, 4>(lds, Y + (size_t)MMAIN * DM, (const bf16_t*)(WOFF), 64, hmeta, X1, DM, 1.0f); EpiRes er{p.out, p.out, X1, rowss, 1.0f}; run_gemm<EpiRes>(lds, Y, (const bf16_t*)(WOFF), DM, DM, er, vcu); } GSYNC();
    conv_ffn(p, 0, 0, (bf16_t*)(ws + WA_UP0), (bf16_t*)(ws + WA_DN0), lds); conv_ffn(p, 0, 1, (bf16_t*)(ws + WA_UP1), (bf16_t*)(ws + WA_DN1), lds);
    convT_job(p.in[11], DM, 3328, p.in[6], (bf16_t*)(ws + WA_INE), -1, lds); convT_job(p.in[16], DM, DM, nullptr, (bf16_t*)(ws + WA_OUTE), -1, lds);
    prep_rows(p, X1, rowss, hmeta);
#ifdef REP_PREP
    prep_rows(p, X1, rowss, hmeta);
#endif
#ifdef REP_P0
    conv_ffn(p, 0, 0, (bf16_t*)(ws + WA_UP0), (bf16_t*)(ws + WA_DN0), lds); conv_ffn(p, 0, 1, (bf16_t*)(ws + WA_UP1), (bf16_t*)(ws + WA_DN1), lds);
    convT_job(p.in[11], DM, 3328, p.in[6], (bf16_t*)(ws + WA_INE), -1, lds); convT_job(p.in[16], DM, DM, nullptr, (bf16_t*)(ws + WA_OUTE), -1, lds);
    prep_rows(p, X1, rowss, hmeta);
#endif
    if (p.nrep == 0x7fffffff) grid.sync();
    GSYNC();
    int vcu = (int)blockIdx.x;
    { unsigned cnts[8];
#pragma unroll
      for (unsigned j = 0; j < 8; ++j) cnts[j] = xb_ld((unsigned*)(ws + OFF_BAR) + XB_XCNT(j));
      bool even = (gridDim.x % 8u) == 0u;
#pragma unroll
      for (unsigned j = 0; j < 8; ++j) even = even & (cnts[j] == gridDim.x / 8u);
      if (even) vcu = (int)xst[2]; }

    GEMM_UP(ws + WA_UP0)
#ifdef PROBE_GEMM_L2
    { pg8::Gemm g{X1, (const bf16_t*)(ws + WA_UP0), MMAIN, 5632, DM}; ProbeOrder S; S.init(MMAIN, 5632, (int)gridDim.x, vcu); NullEpi ne{hmeta}; pg8::gemm_phase<NullEpi, ProbeOrder>(lds, g, S, ne); }
    GSYNC();
#endif
    GEMM_DOWN(ws + WA_DN0, p.in[0])
    { meta_gemm<1, 4>(lds, X1 + (size_t)MMAIN * DM, (const bf16_t*)(ws + WA_INE), 208, hmeta, BIG, LDPE, 0.f); rstd_table(lds, 3328, vcu, rowss); EpiIn ei{BIG, LDPE, rowss}; run_gemm<EpiIn>(lds, X1, (const bf16_t*)(ws + WA_INE), 3328, DM, ei, vcu); } GSYNC();
    hg_phaseA(p, BIG, (bf16_t*)R, dec, lds); pool_items(p.in[12], p.in[13], BIG, Y, lds, (int)blockIdx.x, (int)gridDim.x, POOL_SPLIT);
#ifdef REP_EA
    hg_phaseA(p, BIG, (bf16_t*)R, dec, lds); pool_items(p.in[12], p.in[13], BIG, Y, lds, (int)blockIdx.x, (int)gridDim.x, POOL_SPLIT);
#endif
    GSYNC();
    hg_phaseB((bf16_t*)R, dec);
    {
        const bool g256 = gridDim.x == 256u;
        const int mf = g256 ? ((blockIdx.x >= 192u && blockIdx.x < 198u) ? ((int)blockIdx.x - 192) * NCH : 48 * NCH) : (int)blockIdx.x * NCH, ms = 48 * NCH;
        if (!g256 || blockIdx.x >= 192u) hg_phaseC(p, BIG, (const bf16_t*)R, Y, lds, mf >= 6 * NCH ? 48 * NCH : mf, ms, false);
        const int pf = g256 ? (blockIdx.x >= 200u ? POOL_SPLIT + (int)blockIdx.x - 200 : 513 * 4) : POOL_SPLIT + (int)blockIdx.x, ps = g256 ? 56 : (int)gridDim.x;
        pool_items(p.in[12], p.in[13], BIG, Y, lds, pf, ps, 513 * 4);
    }
    GSYNC();
#ifdef REP_EC
    for (int rep_ = 0; rep_ < p.nrep; ++rep_)
#endif
    hg_phaseC(p, BIG, (const bf16_t*)R, Y, lds, (int)blockIdx.x, (int)gridDim.x, true);
    GSYNC();
    conv_ffn(p, 1, 0, (bf16_t*)(R + WB_UP2), (bf16_t*)(R + WB_DN2), lds); conv_ffn(p, 1, 1, (bf16_t*)(R + WB_UP3), (bf16_t*)(R + WB_DN3), lds);
    convT_job(p.in[17], DM, 2048, p.in[6] + DM, (bf16_t*)(R + WB_INO), -1, lds); convT_job(p.in[29], DM, DM, nullptr, (bf16_t*)(R + WB_OUTO), -1, lds);
#ifdef REP_W1
    conv_ffn(p, 1, 0, (bf16_t*)(R + WB_UP2), (bf16_t*)(R + WB_DN2), lds); conv_ffn(p, 1, 1, (bf16_t*)(R + WB_UP3), (bf16_t*)(R + WB_DN3), lds);
    convT_job(p.in[17], DM, 2048, p.in[6] + DM, (bf16_t*)(R + WB_INO), -1, lds); convT_job(p.in[29], DM, DM, nullptr, (bf16_t*)(R + WB_OUTO), -1, lds);
#endif
    GEMM_OUT(ws + WA_OUTE)
    GEMM_UP(ws + WA_UP1) GEMM_DOWN(ws + WA_DN1, p.out)
    GEMM_UP(R + WB_UP2) GEMM_DOWN(R + WB_DN2, p.out)
    { meta_gemm<1, 4>(lds, X1 + (size_t)MMAIN * DM, (const bf16_t*)(R + WB_INO), 128, hmeta, BIG, LDPO, 0.f); rstd_table(lds, 2048, vcu, rowss); EpiIn ei{BIG, LDPO, rowss}; run_gemm<EpiIn>(lds, X1, (const bf16_t*)(R + WB_INO), 2048, DM, ei, vcu); } GSYNC();
    conv_items(p, BIG, Y, lds); lru_items(p, BIG, (float*)X1, (float*)(ws + OFF_CP), aagg, bagg, lds);
#ifdef REP_OA
    conv_items(p, BIG, Y, lds); lru_items(p, BIG, (float*)X1, (float*)(ws + OFF_CP), aagg, bagg, lds);
#endif
    GSYNC();
    lru_combine(BIG, (const float*)X1, (const float*)(ws + OFF_CP), aagg, bagg, Y, lds); GSYNC();
    GEMM_OUT(R + WB_OUTO)
    GEMM_UP(R + WB_UP3)
    { meta_gemm<2, 11>(lds, BIG + (size_t)MMAIN * DFF, (const bf16_t*)(R + WB_DN3), 64, hmeta, X1, DM, 0.5f);
      EpiFinal ef{p.out, p.out, rowss, (unsigned*)(ws + OFF_FCNT), p.in[30], 0.5f}; run_gemm<EpiFinal>(lds, BIG, (const bf16_t*)(R + WB_DN3), DM, DFF, ef, vcu); }
}

extern "C" void kernel_launch(void* const* d_in, const int* in_sizes, int n_in, void* d_out, int out_size, void* d_ws, size_t ws_size, hipStream_t stream) {
    static int grid_blocks = 0;
    if (!grid_blocks) {
        int dev = 0, cus = 0, per_cu = 0;
        (void)hipGetDevice(&dev);
        (void)hipDeviceGetAttribute(&cus, hipDeviceAttributeMultiprocessorCount, dev);
        (void)hipFuncSetAttribute((const void*)fwd_megakernel, hipFuncAttributeMaxDynamicSharedMemorySize, LDS_BYTES);
        (void)hipOccupancyMaxActiveBlocksPerMultiprocessor(&per_cu, (const void*)fwd_megakernel, 512, LDS_BYTES);
        grid_blocks = cus > 0 ? cus : 256;
        fprintf(stderr, "kernel_launch: cus=%d per_cu=%d grid=%d ws_size=%zu need=%zu n_in=%d\n", cus, per_cu, grid_blocks, ws_size, (size_t)WS_END, n_in);
        if (ws_size < OFF_BAR + 32768 || n_in != 31) { fprintf(stderr, "kernel_launch: workspace too small or wrong input count; nothing launched\n"); grid_blocks = -1; }
    }
    if (grid_blocks < 0) return;
    Params p{};
    for (int i = 0; i < 31; ++i) p.in[i] = (const float*)d_in[i];
    p.out = (float*)d_out; p.ws = (unsigned char*)d_ws; p.nrep = 2; p.pad = 0;
    (void)hipMemsetAsync((unsigned char*)d_ws + OFF_BAR, 0, 32768, stream);
    void* args[] = {&p};
    hipError_t e = hipLaunchCooperativeKernel((const void*)fwd_megakernel, dim3(grid_blocks), dim3(512), args, LDS_BYTES, stream);
    if (e != hipSuccess) fprintf(stderr, "cooperative launch failed: %s (grid %d)\n", hipGetErrorString(e), grid_blocks);
}
```

```cpp
#include <hip/hip_runtime.h>
#include <hip/hip_cooperative_groups.h>
#include <cstdio>
namespace cg = cooperative_groups;
namespace pg8 {
#define PG8_LAS __attribute__((address_space(3)))
typedef unsigned short bf16_t;
typedef short bf16x8 __attribute__((ext_vector_type(8)));
typedef float f32x4 __attribute__((ext_vector_type(4)));
typedef unsigned u32x4 __attribute__((ext_vector_type(4)));
constexpr int BM = 256, BK = 64, HALF = 128, HTB = HALF * BK * 2  , STAGE_BYTES = 8 * HTB, NXCD = 8, WGM = 8;

__host__ __device__ __forceinline__ int lds_byte(int r, int c) { const int st = (r >> 4) * 2 + (c >> 5), rr = r & 15, cc = c & 31, ob = rr * 64 + cc * 2; return st * 1024 + (ob ^ (((ob >> 9) & 1) << 5)); }
__host__ __device__ __forceinline__ void stage_rc(int b, int& R, int& C) { const int st = b / 1024, sb = b % 1024, swz = sb ^ (((sb >> 9) & 1) << 5); R = (st >> 1) * 16 + swz / 64; C = (st & 1) * 32 + (swz % 64) / 2; }
__host__ __device__ __forceinline__ int perm32(int rho) { const int n = rho >> 4, i = rho & 15; return 8 * (i >> 2) + 4 * n + (i & 3); }

struct Unit { int pm, pn; };
struct Gemm { const bf16_t* A; const bf16_t* Bt; int M, N, K; };

struct StaticOrder {
    int nM, nN, nwg, G, c;
    __host__ __device__ void init(int M, int N, int G_, int c_) { nM = M / BM; nN = N / BM; nwg = nM * nN; G = G_; c = c_; }
    __host__ __device__ bool next(int i, Unit& u) const {
        const long L = (long)i * G + c; if (L >= nwg) return false;
        int wgid = (int)L; { const int q = nwg / NXCD, r = nwg % NXCD, xcd = wgid % NXCD, off = wgid / NXCD; wgid = (xcd < r ? xcd * (q + 1) : r * (q + 1) + (xcd - r) * q) + off; }
        const int nig = WGM * nN, gid = wgid / nig, fm = gid * WGM, gsz = (nM - fm) < WGM ? (nM - fm) : WGM;
        u.pm = fm + ((wgid % nig) % gsz); u.pn = (wgid % nig) / gsz; return true;
    }
    __device__ __forceinline__ void a_ready(const Unit&) const {}
    __device__ __forceinline__ void done(const Unit&) const {}
};
template <class Epi, class Sched>
__device__ __forceinline__ void gemm_phase(PG8_LAS unsigned char* lds, const Gemm g, const Sched& S, const Epi& E) {
    int tid_l = (int)threadIdx.x; asm volatile("" : "+v"(tid_l));
    const int tid = tid_l, wid = __builtin_amdgcn_readfirstlane(tid >> 6), lane = tid & 63, wr = wid >> 2, wc = wid & 3, fr = lane & 15, fq = lane >> 4;
    const int K = g.K, nt = K / BK;
    unsigned voffA[2], voffB[2];
#pragma unroll
    for (int i = 0; i < 2; ++i) { int R, C; stage_rc(tid * 16 + i * 8192, R, C); const int Rb = Epi::PERM ? ((R & ~31) + perm32(R & 31)) : R;
        voffA[i] = (unsigned)(R * K + C) * 2u; voffB[i] = (unsigned)(Rb * K + C) * 2u; }
    const size_t kstep = (size_t)(BK * 2);
    const size_t hstep = (size_t)HALF * K * 2;
    const size_t tstep = 2 * hstep;
    const unsigned ldsw = (unsigned)wid * 1024u;
    const int aoff = lds_byte(wr * 64 + fr, fq * 8), boff = lds_byte(wc * 32 + fr, fq * 8);
#define PG8_SA(b, h) (((b) * 2 + (h)) * HTB)
#define PG8_SB(b, h) ((4 + (b) * 2 + (h)) * HTB)
#define PG8_STAGE(bufoff, gbase, voff) do { _Pragma("unroll") for (int _i = 0; _i < 2; ++_i) \
        __builtin_amdgcn_global_load_lds((const unsigned*)((const char*)(gbase) + (voff)[_i]), (PG8_LAS unsigned*)(lds + (bufoff) + ldsw + _i * 8192), 16, 0, 0); } while (0)
#define PG8_LDA(dst, b, h) do { _Pragma("unroll") for (int m = 0; m < 4; ++m) _Pragma("unroll") for (int k = 0; k < 2; ++k) dst[m][k] = *(const PG8_LAS bf16x8*)(lds + PG8_SA(b, h) + aoff + m * 2048 + k * 1024); } while (0)
#define PG8_LDB(dst, b, h) do { _Pragma("unroll") for (int n = 0; n < 2; ++n) _Pragma("unroll") for (int k = 0; k < 2; ++k) dst[n][k] = *(const PG8_LAS bf16x8*)(lds + PG8_SB(b, h) + boff + n * 2048 + k * 1024); } while (0)
#define PG8_MMA(ai, bj, At, Bt) do { __builtin_amdgcn_s_setprio(1); _Pragma("unroll") for (int m = 0; m < 4; ++m) _Pragma("unroll") for (int n = 0; n < 2; ++n) _Pragma("unroll") for (int k = 0; k < 2; ++k) \
        acc[ai][bj][m][n] = __builtin_amdgcn_mfma_f32_16x16x32_bf16(Bt[n][k], At[m][k], acc[ai][bj][m][n], 0, 0, 0); __builtin_amdgcn_s_setprio(0); } while (0)
#define PG8_WAIT_V(n) asm volatile("s_waitcnt vmcnt(" #n ")" ::: "memory")
#define PG8_WAIT_L(n) asm volatile("s_waitcnt lgkmcnt(" #n ")" ::: "memory")
#define PG8_BAR __builtin_amdgcn_s_barrier()
#define PG8_SCHED __builtin_amdgcn_sched_barrier(0)
    Unit cur, nxt; int ui = 0;
    if (!S.next(0, cur)) return;
    f32x4 acc[2][2][4][2];
#pragma unroll
    for (int a = 0; a < 2; ++a)
#pragma unroll
        for (int b = 0; b < 2; ++b)
#pragma unroll
            for (int m = 0; m < 4; ++m)
#pragma unroll
                for (int n = 0; n < 2; ++n) acc[a][b][m][n] = (f32x4){0.f, 0.f, 0.f, 0.f};
    bf16x8 At[4][2], B0[2][2], B1[2][2];
    const char* cA = (const char*)g.A + (size_t)cur.pm * tstep; const char* cB = (const char*)g.Bt + (size_t)cur.pn * tstep;
    S.a_ready(cur);
    PG8_STAGE(PG8_SB(0, 0), cB, voffB); PG8_STAGE(PG8_SA(0, 0), cA, voffA); PG8_STAGE(PG8_SB(0, 1), cB + hstep, voffB); PG8_STAGE(PG8_SA(0, 1), cA + hstep, voffA);
    if (wr == 1) PG8_BAR;
    PG8_WAIT_V(4); PG8_BAR;
    PG8_STAGE(PG8_SB(1, 0), cB + kstep, voffB); PG8_STAGE(PG8_SA(1, 0), cA + kstep, voffA); PG8_STAGE(PG8_SB(1, 1), cB + hstep + kstep, voffB);
    PG8_WAIT_V(6); PG8_BAR;
    for (;;) {
        const bool has_next = S.next(ui + 1, nxt);
        const char* nA = has_next ? (const char*)g.A + (size_t)nxt.pm * tstep : cA; const char* nB = has_next ? (const char*)g.Bt + (size_t)nxt.pn * tstep : cB;
        for (int t = 0; t < nt; t += 2) {
            const bool last = (t == nt - 2);
            const char* a1 = cA + (size_t)(t + 1) * kstep;
            const char* a2 = last ? nA : cA + (size_t)(t + 2) * kstep; const char* b2 = last ? nB : cB + (size_t)(t + 2) * kstep;
            const char* a3 = a2 + kstep; const char* b3 = b2 + kstep;
            if (last && has_next) S.a_ready(nxt);
            PG8_LDB(B0, 0, 0); PG8_SCHED; PG8_LDA(At, 0, 0); PG8_STAGE(PG8_SA(1, 1), a1 + hstep, voffA);
            PG8_WAIT_L(8); PG8_BAR; PG8_WAIT_L(0); PG8_MMA(0, 0, At, B0); PG8_BAR; PG8_SCHED;
            PG8_LDB(B1, 0, 1); PG8_STAGE(PG8_SB(0, 0), b2, voffB);
            PG8_BAR; PG8_WAIT_L(0); PG8_MMA(0, 1, At, B1); PG8_BAR;
            PG8_LDA(At, 0, 1); PG8_STAGE(PG8_SA(0, 0), a2, voffA);
            PG8_BAR; PG8_WAIT_L(0); PG8_MMA(1, 0, At, B0); PG8_BAR; PG8_SCHED;
            PG8_STAGE(PG8_SB(0, 1), b2 + hstep, voffB);
            PG8_WAIT_V(6); PG8_BAR; PG8_MMA(1, 1, At, B1); PG8_BAR;
            PG8_LDB(B0, 1, 0); PG8_SCHED; PG8_LDA(At, 1, 0); PG8_STAGE(PG8_SA(0, 1), a2 + hstep, voffA);
            PG8_WAIT_L(8); PG8_BAR; PG8_WAIT_L(0); PG8_MMA(0, 0, At, B0); PG8_BAR; PG8_SCHED;
            PG8_LDB(B1, 1, 1); PG8_STAGE(PG8_SB(1, 0), b3, voffB);
            PG8_BAR; PG8_WAIT_L(0); PG8_MMA(0, 1, At, B1); PG8_BAR;
            PG8_LDA(At, 1, 1); PG8_STAGE(PG8_SA(1, 0), a3, voffA);
            PG8_BAR; PG8_WAIT_L(0); PG8_MMA(1, 0, At, B0); PG8_BAR; PG8_SCHED;
            PG8_STAGE(PG8_SB(1, 1), b3 + hstep, voffB);
            PG8_WAIT_V(6); PG8_BAR; PG8_MMA(1, 1, At, B1); PG8_BAR;
        }
        if constexpr (!Epi::AFTER_DRAIN) { E(acc, cur, wr, wc, fr, fq, ui, lds); S.done(cur); }
        if (!has_next) break;
#pragma unroll
        for (int a = 0; a < 2; ++a)
#pragma unroll
            for (int b = 0; b < 2; ++b)
#pragma unroll
                for (int m = 0; m < 4; ++m)
#pragma unroll
                    for (int n = 0; n < 2; ++n) acc[a][b][m][n] = (f32x4){0.f, 0.f, 0.f, 0.f};
        cur = nxt; cA = nA; cB = nB; ++ui;
    }
    PG8_WAIT_V(0);
    if (wr == 0) PG8_BAR;
    PG8_BAR;
    if constexpr (Epi::AFTER_DRAIN) { E.fused(acc, cur, wr, wc, fr, fq, lds, wid, lane); S.done(cur); }
#undef PG8_SA
#undef PG8_SB
#undef PG8_STAGE
#undef PG8_LDA
#undef PG8_LDB
#undef PG8_MMA
#undef PG8_WAIT_V
#undef PG8_WAIT_L
#undef PG8_BAR
#undef PG8_SCHED
}
}

using pg8::bf16_t; using pg8::bf16x8; using pg8::f32x4; using pg8::u32x4;
typedef unsigned u32x2 __attribute__((ext_vector_type(2)));
typedef float f32x2v __attribute__((ext_vector_type(2)));
typedef short s16x4 __attribute__((ext_vector_type(4)));
#define LAS __attribute__((address_space(3)))
typedef LAS unsigned char* ldsp_t;
__device__ __forceinline__ bf16x8 tr_frag(const LAS bf16_t* tile, int k0, int n0, int fr, int fq) {
    const LAS s16x4* a = (const LAS s16x4*)(tile + (k0 + 8 * fq + (fr >> 2)) * 136 + n0 + 4 * (fr & 3));
    const s16x4 r0 = __builtin_amdgcn_ds_read_tr16_b64_v4i16((LAS s16x4*)a), r1 = __builtin_amdgcn_ds_read_tr16_b64_v4i16((LAS s16x4*)(a + 136));
    return (bf16x8){r0[0], r0[1], r0[2], r0[3], r1[0], r1[1], r1[2], r1[3]};
}

constexpr int DM = 1024, DFF = 2816, SEQ = 4096;
constexpr int MMAIN = 32768, MPAD = 33024;
constexpr int LDPE = 3328, LDPO = 2048;
constexpr int NCH = 65;
constexpr float EPS = 1e-6f;
constexpr int LDS_BYTES = 155648;
constexpr int POOL_SPLIT = 1536;
constexpr int RSTD_TAB_OFF = 131072;

constexpr size_t SZ_UP = (size_t)5632 * 1024 * 2, SZ_DN = (size_t)1024 * 2816 * 2, SZ_INE = (size_t)3328 * 1024 * 2, SZ_SQ = (size_t)1024 * 1024 * 2, SZ_INO = (size_t)2048 * 1024 * 2;
constexpr size_t WA_UP0 = 0, WA_DN0 = WA_UP0 + SZ_UP, WA_UP1 = WA_DN0 + SZ_DN, WA_DN1 = WA_UP1 + SZ_UP, WA_INE = WA_DN1 + SZ_DN, WA_OUTE = WA_INE + SZ_INE, SZ_WA = WA_OUTE + SZ_SQ;
constexpr size_t SZ_XB = (size_t)MPAD * 1024 * 2;
constexpr size_t OFF_X1 = SZ_WA, OFF_Y = OFF_X1 + SZ_XB, OFF_BIG = OFF_Y + SZ_XB, SZ_BIG = (size_t)MPAD * 3328 * 2, OFF_R = OFF_BIG + SZ_BIG, SZ_R = (size_t)48 * 65 * 16384 * 2;
constexpr size_t OFF_HMETA = OFF_R + SZ_R, OFF_ROWSS = OFF_HMETA + (size_t)256 * 1024 * 4, OFF_DEC = OFF_ROWSS + (size_t)MPAD * 16 * 4, OFF_AAGG = OFF_DEC + (size_t)48 * 65 * 128 * 4,
                 OFF_BAGG = OFF_AAGG + (size_t)8 * 65 * 512 * 4, WS_END = OFF_BAGG + (size_t)8 * 65 * 512 * 4;
constexpr size_t OFF_BAR = WS_END;
constexpr size_t OFF_FCNT = WS_END + 16384;
constexpr size_t WB_UP2 = 0, WB_DN2 = WB_UP2 + SZ_UP, WB_UP3 = WB_DN2 + SZ_DN, WB_DN3 = WB_UP3 + SZ_UP, WB_INO = WB_DN3 + SZ_DN, WB_OUTO = WB_INO + SZ_INO;
constexpr size_t OFF_CP = OFF_BIG + (size_t)MPAD * 2048 * 2;

struct Params { const float* in[31]; float* out; unsigned char* ws; int nrep; int pad; };

__device__ __forceinline__ int opaque_tid() { int t = (int)threadIdx.x; asm volatile("" : "+v"(t)); return t; }
__device__ __forceinline__ void lds_sync() { asm volatile("s_waitcnt lgkmcnt(0)\n\ts_barrier" ::: "memory"); }
__device__ __forceinline__ float bf2f(unsigned v) { return __uint_as_float(v << 16); }
__device__ __forceinline__ unsigned pack2_hw(float lo, float hi) { unsigned r; asm("v_cvt_pk_bf16_f32 %0, %1, %2" : "=v"(r) : "v"(lo), "v"(hi)); return r; }
__device__ __forceinline__ unsigned f2bf_sw(float f) { unsigned u = __float_as_uint(f); u += 0x7FFFu + ((u >> 16) & 1u); return u >> 16; }
__device__ __forceinline__ unsigned pack2_sw(float lo, float hi) { return f2bf_sw(lo) | (f2bf_sw(hi) << 16); }
#ifndef HWCVT_MASK
#define HWCVT_MASK 15
#endif
template <int G> __device__ __forceinline__ unsigned pack2g(float lo, float hi) { if ((HWCVT_MASK >> G) & 1) return pack2_hw(lo, hi); else return pack2_sw(lo, hi); }
template <int G> __device__ __forceinline__ unsigned f2bfg(float f) { if ((HWCVT_MASK >> G) & 1) return pack2_hw(f, 0.0f) & 0xffffu; else return f2bf_sw(f); }
#define pack2 pack2g<CVG>
#define f2bf f2bfg<CVG>
#define CVG 0
__device__ __forceinline__ float lo16(unsigned w) { return __uint_as_float(w << 16); }
__device__ __forceinline__ float hi16(unsigned w) { return __uint_as_float(w & 0xffff0000u); }
__device__ __forceinline__ float sigm(float x) { return __builtin_amdgcn_rcpf(1.0f + __expf(-x)); }
__device__ __forceinline__ float silu(float x) { return x * sigm(x); }
__device__ __forceinline__ float gelu_tanh(float x) { const float y = 0.7978845608028654f * (x + 0.044715f * x * x * x); const float t = 1.0f - 2.0f * __builtin_amdgcn_rcpf(1.0f + __expf(2.0f * y)); return 0.5f * x * (1.0f + t); }
__device__ __forceinline__ int row_of(int b, int t) { return t < 16 ? MMAIN + t : b * SEQ + (t - 16); }

__device__ __forceinline__ float row_rstd(const float* rowss, int row, int fq) {
    const f32x4 p = *(const f32x4*)(rowss + (size_t)row * 16 + 4 * fq);
    float s = (p[0] + p[1]) + (p[2] + p[3]);
    s += __shfl_xor(s, 16); s += __shfl_xor(s, 32);
    return rsqrtf(s * (1.0f / 1024.0f) + EPS);
}

struct EpiUp {
    static constexpr bool PERM = false, AFTER_DRAIN = false;
    bf16_t* act; const float* rowss;
    __device__ __forceinline__ void operator()(const f32x4 (&acc)[2][2][4][2], const pg8::Unit& u, int wr, int wc, int fr, int fq, int ui, ldsp_t lds) const {
        const LAS float* rtab = (const LAS float*)(lds + RSTD_TAB_OFF) + ui * 256 + wr * 64 + fr;
        const int row0 = u.pm * 256 + wr * 64 + fr, j0 = u.pn * 128 + wc * 16 + 4 * fq;
#pragma unroll
        for (int ai = 0; ai < 2; ++ai)
#pragma unroll
            for (int m = 0; m < 4; ++m) {
                const int row = row0 + ai * 128 + m * 16; const float rs = rtab[ai * 128 + m * 16]; bf16_t* rp = act + (size_t)row * DFF + j0;
#pragma unroll
                for (int bj = 0; bj < 2; ++bj) {
                    const f32x4 g = acc[ai][bj][m][0] * rs, uu = acc[ai][bj][m][1] * rs; const f32x4 t = g * -1.4426950408889634f;
                    f32x4 e; e[0] = __builtin_amdgcn_exp2f(t[0]); e[1] = __builtin_amdgcn_exp2f(t[1]); e[2] = __builtin_amdgcn_exp2f(t[2]); e[3] = __builtin_amdgcn_exp2f(t[3]);
                    const f32x4 d = e + 1.0f; f32x4 r; r[0] = __builtin_amdgcn_rcpf(d[0]); r[1] = __builtin_amdgcn_rcpf(d[1]); r[2] = __builtin_amdgcn_rcpf(d[2]); r[3] = __builtin_amdgcn_rcpf(d[3]);
                    const f32x4 o = (g * uu) * r;
                    u32x2 w; w.x = pack2(o[0], o[1]); w.y = pack2(o[2], o[3]);
                    *(u32x2*)(rp + bj * 64) = w; }
            }
    }
};
struct EpiIn {
    static constexpr bool PERM = false, AFTER_DRAIN = false;
    bf16_t* P; int ldp; const float* rowss;
    __device__ __forceinline__ void operator()(const f32x4 (&acc)[2][2][4][2], const pg8::Unit& u, int wr, int wc, int fr, int fq, int ui, ldsp_t lds) const {
        const LAS float* rtab = (const LAS float*)(lds + RSTD_TAB_OFF) + ui * 256 + wr * 64 + fr;
        const int row0 = u.pm * 256 + wr * 64 + fr, col0 = u.pn * 256 + wc * 32 + 4 * fq;
#pragma unroll
        for (int ai = 0; ai < 2; ++ai)
#pragma unroll
            for (int m = 0; m < 4; ++m) {
                const int row = row0 + ai * 128 + m * 16; const float rs = rtab[ai * 128 + m * 16]; bf16_t* rp = P + (size_t)row * ldp + col0;
#pragma unroll
                for (int bj = 0; bj < 2; ++bj)
#pragma unroll
                    for (int n = 0; n < 2; ++n) { const f32x4 v = acc[ai][bj][m][n] * rs; u32x2 w; w.x = pack2(v[0], v[1]); w.y = pack2(v[2], v[3]); *(u32x2*)(rp + bj * 128 + n * 16) = w; }
            }
    }
};
struct EpiRes {
    static constexpr bool PERM = false, AFTER_DRAIN = false;
    const float* base; float* h; bf16_t* hb; float* rowss; float alpha;
    __device__ __forceinline__ void operator()(const f32x4 (&acc)[2][2][4][2], const pg8::Unit& u, int wr, int wc, int fr, int fq, int, ldsp_t) const {
        const int row0 = u.pm * 256 + wr * 64 + fr, col0 = u.pn * 256 + wc * 32 + 4 * fq;
#pragma unroll
        for (int ai = 0; ai < 2; ++ai) {
            f32x4 bv[4][2][2];
#pragma unroll
            for (int m = 0; m < 4; ++m)
#pragma unroll
                for (int bj = 0; bj < 2; ++bj)
#pragma unroll
                    for (int n = 0; n < 2; ++n) bv[m][bj][n] = *(const f32x4*)(base + (size_t)(row0 + ai * 128 + m * 16) * 1024 + col0 + bj * 128 + n * 16);
            asm volatile("" ::: "memory");
#pragma unroll
            for (int m = 0; m < 4; ++m) {
                const int row = row0 + ai * 128 + m * 16; const size_t off = (size_t)row * 1024 + col0; float ss = 0.f;
#pragma unroll
                for (int bj = 0; bj < 2; ++bj)
#pragma unroll
                    for (int n = 0; n < 2; ++n) { const size_t o = off + bj * 128 + n * 16; const f32x4 hv = bv[m][bj][n] + alpha * acc[ai][bj][m][n];
                        *(f32x4*)(h + o) = hv; u32x2 w; w.x = pack2(hv[0], hv[1]); w.y = pack2(hv[2], hv[3]); *(u32x2*)(hb + o) = w;
                        ss += (hv[0] * hv[0] + hv[1] * hv[1]) + (hv[2] * hv[2] + hv[3] * hv[3]); }
                ss += __shfl_xor(ss, 16); ss += __shfl_xor(ss, 32);
                if (fq == 0) rowss[(size_t)row * 16 + u.pn * 4 + wc] = ss;
            }
        }
    }
};

struct EpiFinal {
    static constexpr bool PERM = false, AFTER_DRAIN = false;
    const float* base; float* out; float* xch; unsigned* cnt; const float* gain; float alpha;
    __device__ __forceinline__ void operator()(const f32x4 (&acc)[2][2][4][2], const pg8::Unit& u, int wr, int wc, int fr, int fq, int, ldsp_t) const {
        const int row0 = u.pm * 256 + wr * 64 + fr, col0 = u.pn * 256 + wc * 32 + 4 * fq;
        f32x4 (&hw)[2][2][4][2] = const_cast<f32x4 (&)[2][2][4][2]>(acc);
#pragma unroll
        for (int ai = 0; ai < 2; ++ai) {
            f32x4 bv[4][2][2];
#pragma unroll
            for (int m = 0; m < 4; ++m)
#pragma unroll
                for (int bj = 0; bj < 2; ++bj)
#pragma unroll
                    for (int n = 0; n < 2; ++n) bv[m][bj][n] = *(const f32x4*)(base + (size_t)(row0 + ai * 128 + m * 16) * 1024 + col0 + bj * 128 + n * 16);
            asm volatile("" ::: "memory");
#pragma unroll
            for (int m = 0; m < 4; ++m) {
                const int row = row0 + ai * 128 + m * 16; float ss = 0.f;
#pragma unroll
                for (int bj = 0; bj < 2; ++bj)
#pragma unroll
                    for (int n = 0; n < 2; ++n) { const f32x4 h4 = bv[m][bj][n] + alpha * acc[ai][bj][m][n]; hw[ai][bj][m][n] = h4; ss += (h4[0] * h4[0] + h4[1] * h4[1]) + (h4[2] * h4[2] + h4[3] * h4[3]); }
                ss += __shfl_xor(ss, 16); ss += __shfl_xor(ss, 32);
                if (fq == 0) __hip_atomic_store(xch + (size_t)row * 16 + u.pn * 4 + wc, ss, __ATOMIC_RELAXED, __HIP_MEMORY_SCOPE_AGENT);
            }
        }
        asm volatile("s_waitcnt vmcnt(0)" ::: "memory");
        unsigned* cp = cnt + (size_t)(u.pm * 2 + wr) * 16;
        if ((fr | fq) == 0) __hip_atomic_fetch_add(cp, 1u, __ATOMIC_RELAXED, __HIP_MEMORY_SCOPE_AGENT);
        { unsigned sp = 0;
          while ((unsigned)__builtin_amdgcn_readfirstlane(__hip_atomic_load(cp, __ATOMIC_RELAXED, __HIP_MEMORY_SCOPE_AGENT)) < 16u) { __builtin_amdgcn_s_sleep(1); if (++sp > (1u << 18)) break; } }
        asm volatile("" ::: "memory");
        f32x4 gv[2][2];
#pragma unroll
        for (int bj = 0; bj < 2; ++bj)
#pragma unroll
            for (int n = 0; n < 2; ++n) gv[bj][n] = *(const f32x4*)(gain + col0 + bj * 128 + n * 16);
#pragma unroll
        for (int ai = 0; ai < 2; ++ai)
#pragma unroll
            for (int m = 0; m < 4; ++m) {
                const int row = row0 + ai * 128 + m * 16; const float* xp = xch + (size_t)row * 16 + 4 * fq;
                float s = (__hip_atomic_load(xp, __ATOMIC_RELAXED, __HIP_MEMORY_SCOPE_AGENT) + __hip_atomic_load(xp + 1, __ATOMIC_RELAXED, __HIP_MEMORY_SCOPE_AGENT)) + (__hip_atomic_load(xp + 2, __ATOMIC_RELAXED, __HIP_MEMORY_SCOPE_AGENT) + __hip_atomic_load(xp + 3, __ATOMIC_RELAXED, __HIP_MEMORY_SCOPE_AGENT));
                s += __shfl_xor(s, 16); s += __shfl_xor(s, 32);
                const float rs = rsqrtf(s * (1.0f / 1024.0f) + EPS);
#pragma unroll
                for (int bj = 0; bj < 2; ++bj)
#pragma unroll
                    for (int n = 0; n < 2; ++n) *(f32x4*)(out + (size_t)row * 1024 + col0 + bj * 128 + n * 16) = hw[ai][bj][m][n] * rs * gv[bj][n];
            }
    }
};

__device__ __forceinline__ f32x4 mfma16(bf16x8 a, bf16x8 b, f32x4 c) { return __builtin_amdgcn_mfma_f32_16x16x32_bf16(a, b, c, 0, 0, 0); }
template <int MODE, int NS>
__device__ __noinline__ void meta_gemm(ldsp_t lds, const bf16_t* A, const bf16_t* Bt, int ntasks, float* hmeta, bf16_t* outb, int ldo, float alpha) {
    constexpr int K = 256 * NS;
    LAS float* part = (LAS float*)lds;
    LAS float* rs = (LAS float*)(lds + 16384);
    const int tid = opaque_tid(), lane = tid & 63, w = tid >> 6, fr = lane & 15, fq = lane >> 4;
    for (int t = blockIdx.x; t < ntasks; t += gridDim.x) {
        bf16x8 av[NS], bv[NS], bw[MODE == 0 ? NS : 1];
        { const bf16_t* ap = A + (size_t)fr * K + 8 * fq + 32 * w;
          const bf16_t* b0 = Bt + (size_t)((MODE == 0 ? 32 * t : 16 * t) + fr) * K + 8 * fq + 32 * w;
#pragma unroll
          for (int i = 0; i < NS; ++i) { av[i] = *(const bf16x8*)(ap + 256 * i); bv[i] = *(const bf16x8*)(b0 + 256 * i); if (MODE == 0) bw[i] = *(const bf16x8*)(b0 + (size_t)16 * K + 256 * i); } }
        if (MODE != 2) {
#pragma unroll
            for (int rr = 0; rr < 2; ++rr) { const int row = 2 * w + rr; float ss = 0.f;
#pragma unroll
                for (int i = 0; i < 4; ++i) { const f32x4 v = *(const f32x4*)(hmeta + (size_t)row * DM + i * 256 + lane * 4); ss += (v[0] * v[0] + v[1] * v[1]) + (v[2] * v[2] + v[3] * v[3]); }
#pragma unroll
                for (int o = 32; o >= 1; o >>= 1) ss += __shfl_xor(ss, o);
                if (lane == 0) rs[row] = rsqrtf(ss * (1.0f / 1024.0f) + EPS); }
        }
        f32x4 acc0 = {0.f, 0.f, 0.f, 0.f}, acc1 = {0.f, 0.f, 0.f, 0.f};
#pragma unroll
        for (int i = 0; i < NS; ++i) { acc0 = mfma16(av[i], bv[i], acc0); if (MODE == 0) acc1 = mfma16(av[i], bw[i], acc1); }
        *(LAS f32x4*)(part + ((w * 2 + 0) * 64 + lane) * 4) = acc0; if (MODE == 0) *(LAS f32x4*)(part + ((w * 2 + 1) * 64 + lane) * 4) = acc1;
        __syncthreads();
        if (tid < 256) { const int e = tid & 3, ln = tid >> 2; float s0 = 0.f, s1 = 0.f;
#pragma unroll
            for (int ww = 0; ww < 8; ++ww) { s0 += part[((ww * 2 + 0) * 64 + ln) * 4 + e]; if (MODE == 0) s1 += part[((ww * 2 + 1) * 64 + ln) * 4 + e]; }
            const int row = 4 * (ln >> 4) + e, col = 16 * t + (ln & 15);
            if (MODE == 0) { const float r = rs[row]; outb[(size_t)(MMAIN + row) * ldo + col] = (bf16_t)f2bf(silu(s0 * r) * (s1 * r)); }
            else if (MODE == 1) { outb[(size_t)(MMAIN + row) * ldo + col] = (bf16_t)f2bf(s0 * rs[row]); }
            else { const float hv = hmeta[(size_t)row * DM + col] + alpha * s0; hmeta[(size_t)row * DM + col] = hv; outb[(size_t)(MMAIN + row) * ldo + col] = (bf16_t)f2bf(hv); } }
        __syncthreads();
    }
}

#undef CVG
#define CVG 1
__device__ void convT_job(const float* __restrict__ src, int K, int N, const float* __restrict__ gain, bf16_t* __restrict__ dst, int which, ldsp_t) {
    const int tid_ = opaque_tid(); const int lane = tid_ & 63, gw = blockIdx.x * 8 + (tid_ >> 6), nw = gridDim.x * 8;
    const int nnb = N >> 6, ntask = (K >> 5) * nnb;
    float v[32], nv[32];
#define CONVT_LOAD(DST, T) { const float* sp_ = src + (size_t)(((T) / nnb) << 5) * N + (((T) % nnb) << 6) + lane; \
        _Pragma("unroll") for (int i = 0; i < 32; ++i) DST[i] = sp_[(size_t)i * N]; }
    int t = gw;
    if (t < ntask) CONVT_LOAD(v, t)
    while (t < ntask) {
        const int nt = t + nw;
        if (nt < ntask) CONVT_LOAD(nv, nt)
        asm volatile("" ::: "memory");
        const int k0 = (t / nnb) << 5, j = ((t % nnb) << 6) + lane;
        if (gain) {
#pragma unroll
            for (int i = 0; i < 32; i += 4) { const f32x4 g = *(const f32x4*)(gain + k0 + i); v[i] *= g[0]; v[i + 1] *= g[1]; v[i + 2] *= g[2]; v[i + 3] *= g[3]; } }
        const int drow = which < 0 ? j : ((j >> 4) * 32 + which * 16 + (j & 15));
        bf16_t* dp = dst + (size_t)drow * K + k0;
#pragma unroll
        for (int i = 0; i < 32; i += 8) { u32x4 w; w.x = pack2(v[i], v[i + 1]); w.y = pack2(v[i + 2], v[i + 3]); w.z = pack2(v[i + 4], v[i + 5]); w.w = pack2(v[i + 6], v[i + 7]); *(u32x4*)(dp + i) = w; }
#pragma unroll
        for (int i = 0; i < 32; ++i) v[i] = nv[i];
        t = nt;
    }
#undef CONVT_LOAD
}
__device__ void conv_ffn(const Params& p, int l, int second, bf16_t* up, bf16_t* dn, ldsp_t lds) {
    const float* nrm = p.in[second ? 7 : 2] + (size_t)l * DM;
    const float* wg = p.in[second ? 8 : 3] + (size_t)l * DM * DFF; const float* wu = p.in[second ? 9 : 4] + (size_t)l * DM * DFF; const float* wd = p.in[second ? 10 : 5] + (size_t)l * DFF * DM;
    convT_job(wg, DM, DFF, nrm, up, 0, lds); convT_job(wu, DM, DFF, nrm, up, 1, lds); convT_job(wd, DFF, DM, nullptr, dn, -1, lds);
}
__device__ void prep_rows(const Params& p, bf16_t* __restrict__ HB, float* __restrict__ rowss, float* __restrict__ hmeta) {
    const int tid_ = opaque_tid(); const int lane = tid_ & 63, gw = blockIdx.x * 8 + (tid_ >> 6), nw = gridDim.x * 8;
    f32x4 v[4], nv[4];
#define PREP_LOAD(DST, ROW) { const float* src_ = (ROW) < MMAIN ? p.in[0] + (size_t)(ROW) * DM : ((ROW) < MMAIN + 16 ? p.in[1] + (size_t)((ROW) - MMAIN) * DM : nullptr); \
        _Pragma("unroll") for (int i = 0; i < 4; ++i) { DST[i] = (f32x4){0.f, 0.f, 0.f, 0.f}; if (src_) DST[i] = *(const f32x4*)(src_ + i * 256 + lane * 4); } }
    int row = gw;
    if (row < MPAD) PREP_LOAD(v, row)
    while (row < MPAD) {
        const int nrow = row + nw;
        if (nrow < MPAD) PREP_LOAD(nv, nrow)
        float ss = 0.f;
#pragma unroll
        for (int i = 0; i < 4; ++i) { const int col = i * 256 + lane * 4;
            ss += (v[i][0] * v[i][0] + v[i][1] * v[i][1]) + (v[i][2] * v[i][2] + v[i][3] * v[i][3]);
            u32x2 w; w.x = pack2(v[i][0], v[i][1]); w.y = pack2(v[i][2], v[i][3]); *(u32x2*)(HB + (size_t)row * DM + col) = w;
            if (row >= MMAIN) *(f32x4*)(hmeta + (size_t)(row - MMAIN) * DM + col) = v[i]; }
#pragma unroll
        for (int o = 32; o >= 1; o >>= 1) ss += __shfl_xor(ss, o);
        if (lane < 16) rowss[(size_t)row * 16 + lane] = lane == 0 ? ss : 0.f;
#pragma unroll
        for (int i = 0; i < 4; ++i) v[i] = nv[i];
        row = nrow;
    }
#undef PREP_LOAD
}

#undef CVG
#define CVG 2
__device__ void hg_phaseA(const Params& p, const bf16_t* P, bf16_t* states, float* dec, ldsp_t lds) {
    LAS float* Lb = (LAS float*)lds;
    LAS bf16_t* Z = (LAS bf16_t*)(lds + 32768);
    LAS bf16_t* VT = (LAS bf16_t*)(lds + 49152);
    LAS bf16_t* KlT = (LAS bf16_t*)(lds + 49152 + 18432);
    LAS float* Tot = (LAS float*)(lds + 49152 + 36864);
    const int tid = opaque_tid(), lane = tid & 63, w = __builtin_amdgcn_readfirstlane(tid >> 6), fr = lane & 15, fq = lane >> 4;
    const float* lbl = p.in[14];
    const int NIT = 48 * 64;
    float lb6a[6], lb6b[6];
#pragma unroll
    for (int hq = 0; hq < 6; ++hq) { lb6a[hq] = sigm(lbl[128 * hq + 2 * lane] - lbl[768 + 128 * hq + 2 * lane]); lb6b[hq] = sigm(lbl[128 * hq + 2 * lane + 1] - lbl[768 + 128 * hq + 2 * lane + 1]); }
    u32x4 pz[2], pv[2];
#define EA_LOAD(IT) { const int c_ = (IT) & 63, bh_ = (IT) >> 6, b_ = bh_ / 6, h_ = bh_ % 6; \
        _Pragma("unroll") for (int i = 0; i < 2; ++i) { const int idx = tid + 512 * i, s = idx >> 4, c8 = (idx & 15) * 8; const bool valid = c_ > 0 || s < 16; \
            const int row = c_ == 0 ? MMAIN + s : b_ * SEQ + 64 * (c_ - 1) + s; pz[i] = (u32x4){0u, 0u, 0u, 0u}; pv[i] = (u32x4){0u, 0u, 0u, 0u}; \
            if (valid) { pz[i] = *(const u32x4*)(P + (size_t)row * LDPE + 1024 + 128 * h_ + c8); pv[i] = *(const u32x4*)(P + (size_t)row * LDPE + 1792 + 128 * h_ + c8); } } }
    int it = blockIdx.x;
    if (it < NIT) EA_LOAD(it)
    while (it < NIT) {
        const int c = it & 63, bh = it >> 6, h = bh % 6;
#pragma unroll
        for (int i = 0; i < 2; ++i) {
            const int idx = tid + 512 * i, s = idx >> 4, c8 = (idx & 15) * 8;
            *(LAS u32x4*)(Z + s * 128 + c8) = pz[i];
            *(LAS u32x4*)(VT + s * 136 + c8) = pv[i];
        }
        lds_sync();
        const int nit = it + (int)gridDim.x;
        if (nit < NIT) EA_LOAD(nit)
        const float lbA = h == 0 ? lb6a[0] : (h == 1 ? lb6a[1] : (h == 2 ? lb6a[2] : (h == 3 ? lb6a[3] : (h == 4 ? lb6a[4] : lb6a[5]))));
        const float lbB = h == 0 ? lb6b[0] : (h == 1 ? lb6b[1] : (h == 2 ? lb6b[2] : (h == 3 ? lb6b[3] : (h == 4 ? lb6b[4] : lb6b[5]))));
        {
            float runA = 0.f, runB = 0.f;
#pragma unroll
            for (int q = 0; q < 8; ++q) { const int s = 8 * w + q; const bool valid = c > 0 || s < 16; const unsigned zz = *(const LAS unsigned*)(Z + s * 128 + 2 * lane);
                const float sgA = sigm(lo16(zz)), sgB = sigm(hi16(zz)); const float fA = lbA + (1.0f - lbA) * sgA, fB = lbB + (1.0f - lbB) * sgB;
                runA += valid ? __logf(fA) : 0.f; runB += valid ? __logf(fB) : 0.f;
                *(LAS f32x2v*)(Lb + s * 128 + 2 * lane) = (f32x2v){runA, runB};
                *(LAS unsigned*)(Z + s * 128 + 2 * lane) = pack2(valid ? (1.0f - lbA) * (1.0f - sgA) : 0.f, valid ? (1.0f - lbB) * (1.0f - sgB) : 0.f); }
            *(LAS f32x2v*)(Tot + w * 128 + 2 * lane) = (f32x2v){runA, runB};
        }
        lds_sync();
        {
            f32x2v T[8];
#pragma unroll
            for (int g = 0; g < 8; ++g) T[g] = *(const LAS f32x2v*)(Tot + g * 128 + 2 * lane);
            f32x2v tail = {0.f, 0.f};
#pragma unroll
            for (int g = 7; g >= 0; --g) { if (g > w) tail += T[g]; }
            f32x2v mine = {0.f, 0.f};
#pragma unroll
            for (int g = 0; g < 8; ++g) { if (g == w) mine = T[g]; }
            float klA[8], klB[8];
#pragma unroll
            for (int q = 0; q < 8; ++q) { const int s = 8 * w + q; const unsigned kz = *(const LAS unsigned*)(Z + s * 128 + 2 * lane); const f32x2v lc = *(const LAS f32x2v*)(Lb + s * 128 + 2 * lane);
                klA[q] = lo16(kz) * __expf(tail[0] + (mine[0] - lc[0])); klB[q] = hi16(kz) * __expf(tail[1] + (mine[1] - lc[1])); }
            u32x4 wA = {pack2(klA[0], klA[1]), pack2(klA[2], klA[3]), pack2(klA[4], klA[5]), pack2(klA[6], klA[7])}, wB = {pack2(klB[0], klB[1]), pack2(klB[2], klB[3]), pack2(klB[4], klB[5]), pack2(klB[6], klB[7])};
            *(LAS u32x4*)(KlT + (2 * lane) * 72 + 8 * w) = wA; *(LAS u32x4*)(KlT + (2 * lane + 1) * 72 + 8 * w) = wB;
            if (w == 0) { f32x2v bl = {0.f, 0.f};
#pragma unroll
                for (int g = 0; g < 8; ++g) bl += T[g];
                *(f32x2v*)(dec + ((size_t)bh * NCH + c) * 128 + 2 * lane) = (f32x2v){__expf(bl[0]), __expf(bl[1])}; }
        }
        lds_sync();
        {
            f32x4 acc[8];
#pragma unroll
            for (int vb = 0; vb < 8; ++vb) acc[vb] = (f32x4){0.f, 0.f, 0.f, 0.f};
#pragma unroll
            for (int kk = 0; kk < 2; ++kk) {
                const bf16x8 a = *(const LAS bf16x8*)(KlT + (16 * w + fr) * 72 + 32 * kk + 8 * fq);
#pragma unroll
                for (int vb = 0; vb < 8; ++vb) { const bf16x8 bb = tr_frag(VT, 32 * kk, 16 * vb, fr, fq); acc[vb] = mfma16(a, bb, acc[vb]); }
            }
            bf16_t* st = states + ((size_t)bh * NCH + c) * 16384;
            float one = 1.0f; asm volatile("" : "+v"(one));
#pragma unroll
            for (int vb = 0; vb < 8; ++vb) { const f32x4 av = acc[vb] * one; u32x2 o; o.x = pack2(av[0], av[1]); o.y = pack2(av[2], av[3]); *(u32x2*)(st + (16 * vb + fr) * 128 + 16 * w + 4 * fq) = o; }
        }
        lds_sync();
        it = nit;
    }
#undef EA_LOAD
}

__device__ void hg_phaseB(bf16_t* __restrict__ states, const float* __restrict__ dec) {
    const int idx = blockIdx.x * 512 + opaque_tid();
    if (idx >= 48 * 2048) return;
    const int bh = idx >> 11, e8 = idx & 2047, k0 = (e8 & 15) * 8;
    bf16_t* sp = states + (size_t)bh * NCH * 16384 + (size_t)e8 * 8; const float* dp = dec + (size_t)bh * NCH * 128 + k0;
    float S[8];
#pragma unroll
    for (int e = 0; e < 8; ++e) S[e] = 0.f;
    u32x4 u[4], nu[4]; f32x4 d0[4], d1[4], nd0[4], nd1[4];
#pragma unroll
    for (int j = 0; j < 4; ++j) { u[j] = *(const u32x4*)(sp + (size_t)j * 16384); d0[j] = *(const f32x4*)(dp + j * 128); d1[j] = *(const f32x4*)(dp + j * 128 + 4); }
    for (int c0 = 0; c0 < 64; c0 += 4) {
        if (c0 + 4 < 64) {
#pragma unroll
            for (int j = 0; j < 4; ++j) { nu[j] = *(const u32x4*)(sp + (size_t)(c0 + 4 + j) * 16384); nd0[j] = *(const f32x4*)(dp + (c0 + 4 + j) * 128); nd1[j] = *(const f32x4*)(dp + (c0 + 4 + j) * 128 + 4); }
        }
#pragma unroll
        for (int j = 0; j < 4; ++j) {
            u32x4 o; o.x = pack2(S[0], S[1]); o.y = pack2(S[2], S[3]); o.z = pack2(S[4], S[5]); o.w = pack2(S[6], S[7]);
            *(u32x4*)(sp + (size_t)(c0 + j) * 16384) = o;
            S[0] = d0[j][0] * S[0] + lo16(u[j].x); S[1] = d0[j][1] * S[1] + hi16(u[j].x); S[2] = d0[j][2] * S[2] + lo16(u[j].y); S[3] = d0[j][3] * S[3] + hi16(u[j].y);
            S[4] = d1[j][0] * S[4] + lo16(u[j].z); S[5] = d1[j][1] * S[5] + hi16(u[j].z); S[6] = d1[j][2] * S[6] + lo16(u[j].w); S[7] = d1[j][3] * S[7] + hi16(u[j].w);
        }
#pragma unroll
        for (int j = 0; j < 4; ++j) { u[j] = nu[j]; d0[j] = nd0[j]; d1[j] = nd1[j]; }
    }
    u32x4 o; o.x = pack2(S[0], S[1]); o.y = pack2(S[2], S[3]); o.z = pack2(S[4], S[5]); o.w = pack2(S[6], S[7]);
    *(u32x4*)(sp + (size_t)64 * 16384) = o;
}

__device__ void hg_phaseC(const Params& p, const bf16_t* P, const bf16_t* states, bf16_t* Y, ldsp_t lds) {
    LAS float* Lb = (LAS float*)lds;
    LAS bf16_t* Z = (LAS bf16_t*)(lds + 32768);
    LAS bf16_t* Qb = (LAS bf16_t*)(lds + 49152);
    LAS bf16_t* Qd = (LAS bf16_t*)(lds + 66560);
    LAS bf16_t* Kd = (LAS bf16_t*)(lds + 83968);
    LAS bf16_t* VT = (LAS bf16_t*)(lds + 127488);
    LAS bf16_t* Am = (LAS bf16_t*)(lds + 145920);
    LAS float* Tot = (LAS float*)(lds + 145920);
    LAS float* O = (LAS float*)lds;
    const int tid = opaque_tid(), lane = tid & 63, w = __builtin_amdgcn_readfirstlane(tid >> 6), fr = lane & 15, fq = lane >> 4;
    const float* lbl = p.in[14]; const float* gnorm = p.in[15];
    const int NIT = 48 * NCH;
    float lb6a[6], lb6b[6];
#pragma unroll
    for (int hq = 0; hq < 6; ++hq) { lb6a[hq] = sigm(lbl[128 * hq + 2 * lane] - lbl[768 + 128 * hq + 2 * lane]); lb6b[hq] = sigm(lbl[128 * hq + 2 * lane + 1] - lbl[768 + 128 * hq + 2 * lane + 1]); }
    u32x4 pq[2], pz[2], pv[2];
#define EC_SKIP(IT) (((IT) % NCH) == 0 && ((IT) / NCH) >= 6)
#define EC_LOAD(IT) { const int c_ = (IT) % NCH, bh_ = (IT) / NCH, b_ = bh_ / 6, h_ = bh_ % 6; \
        _Pragma("unroll") for (int i = 0; i < 2; ++i) { const int idx = tid + 512 * i, s = idx >> 4, c8 = (idx & 15) * 8; const bool valid = c_ > 0 || s < 16; \
            const int row = c_ == 0 ? MMAIN + s : b_ * SEQ + 64 * (c_ - 1) + s; pq[i] = (u32x4){0u, 0u, 0u, 0u}; pz[i] = (u32x4){0u, 0u, 0u, 0u}; pv[i] = (u32x4){0u, 0u, 0u, 0u}; \
            if (valid) { const bf16_t* pr = P + (size_t)row * LDPE + 128 * h_ + c8; pq[i] = *(const u32x4*)(pr + 256); pz[i] = *(const u32x4*)(pr + 1024); pv[i] = *(const u32x4*)(pr + 1792); } } }
    int it = blockIdx.x;
    while (it < NIT && EC_SKIP(it)) it += (int)gridDim.x;
    if (it < NIT) EC_LOAD(it)
    while (it < NIT) {
        const int c = it % NCH, bh = it / NCH, b = bh / 6, h = bh % 6;
#pragma unroll
        for (int i = 0; i < 2; ++i) {
            const int idx = tid + 512 * i, s = idx >> 4, c8 = (idx & 15) * 8;
            *(LAS u32x4*)(Z + s * 128 + c8) = pz[i]; *(LAS u32x4*)(Qd + s * 136 + c8) = pq[i];
            *(LAS u32x4*)(VT + s * 136 + c8) = pv[i];
        }
        lds_sync();
        int nit = it + (int)gridDim.x;
        while (nit < NIT && EC_SKIP(nit)) nit += (int)gridDim.x;
        const int tb = w >> 1, vb0 = 4 * (w & 1);
        const int tn = tid >> 3, v0 = (tid & 7) * 16; const bool nvalid = c > 0 || tn < 16; const int nrow = c == 0 ? MMAIN + tn : b * SEQ + 64 * (c - 1) + tn;
        f32x4 gnv[4];
#pragma unroll
        for (int i = 0; i < 4; ++i) gnv[i] = *(const f32x4*)(gnorm + v0 + 4 * i);
        u32x4 g0 = {0u, 0u, 0u, 0u}, g1 = {0u, 0u, 0u, 0u};
        if (nvalid) { const bf16_t* gp = P + (size_t)nrow * LDPE + 2560 + 128 * h + v0; g0 = *(const u32x4*)gp; g1 = *(const u32x4*)(gp + 8); }
        const float lbA = h == 0 ? lb6a[0] : (h == 1 ? lb6a[1] : (h == 2 ? lb6a[2] : (h == 3 ? lb6a[3] : (h == 4 ? lb6a[4] : lb6a[5]))));
        const float lbB = h == 0 ? lb6b[0] : (h == 1 ? lb6b[1] : (h == 2 ? lb6b[2] : (h == 3 ? lb6b[3] : (h == 4 ? lb6b[4] : lb6b[5]))));
        {
            float runA = 0.f, runB = 0.f;
#pragma unroll
            for (int q = 0; q < 8; ++q) { const int s = 8 * w + q; const bool valid = c > 0 || s < 16; const unsigned zz = *(const LAS unsigned*)(Z + s * 128 + 2 * lane);
                const float sgA = sigm(lo16(zz)), sgB = sigm(hi16(zz)); const float fA = lbA + (1.0f - lbA) * sgA, fB = lbB + (1.0f - lbB) * sgB;
                runA += valid ? __logf(fA) : 0.f; runB += valid ? __logf(fB) : 0.f;
                *(LAS f32x2v*)(Lb + s * 128 + 2 * lane) = (f32x2v){runA, runB};
                *(LAS unsigned*)(Z + s * 128 + 2 * lane) = pack2(valid ? (1.0f - lbA) * (1.0f - sgA) : 0.f, valid ? (1.0f - lbB) * (1.0f - sgB) : 0.f); }
            *(LAS f32x2v*)(Tot + w * 128 + 2 * lane) = (f32x2v){runA, runB};
        }
        lds_sync();
        {
            f32x2v T[7];
#pragma unroll
            for (int g = 0; g < 7; ++g) T[g] = *(const LAS f32x2v*)(Tot + g * 128 + 2 * lane);
            const f32x2v r1 = T[0] + T[1], r2 = r1 + (T[2] + T[3]), r3 = r2 + (T[4] + T[5]);
            const f32x2v E1 = {__expf(r1[0]), __expf(r1[1])}, E2 = {__expf(r2[0]), __expf(r2[1])}, E3 = {__expf(r3[0]), __expf(r3[1])};
            const f32x2v D12 = {__expf(r2[0] - r1[0]), __expf(r2[1] - r1[1])}, D13 = {__expf(r3[0] - r1[0]), __expf(r3[1] - r1[1])}, D23 = {__expf(r3[0] - r2[0]), __expf(r3[1] - r2[1])};
            const f32x2v one2 = {1.0f, 1.0f};
#pragma unroll
            for (int q = 0; q < 8; ++q) {
                const int s = w + 8 * q; const bool valid = c > 0 || s < 16; constexpr int dummy = 0; (void)dummy;
                const int sub = q >> 1;
                const unsigned kz = *(const LAS unsigned*)(Z + s * 128 + 2 * lane); f32x2v bl = *(const LAS f32x2v*)(Lb + s * 128 + 2 * lane); const unsigned qr = *(const LAS unsigned*)(Qd + s * 136 + 2 * lane);
                if (q & 1) bl += T[q - 1];
                const f32x2v eb = {__expf(bl[0]), __expf(bl[1])}; const f32x2v ieb = {__builtin_amdgcn_rcpf(eb[0]), __builtin_amdgcn_rcpf(eb[1])};
                const f32x2v qv = {valid ? silu(lo16(qr)) : 0.f, valid ? silu(hi16(qr)) : 0.f}; const f32x2v qe = qv * eb; const f32x2v ki = (f32x2v){lo16(kz), hi16(kz)} * ieb;
                const f32x2v Es = sub == 0 ? one2 : (sub == 1 ? E1 : (sub == 2 ? E2 : E3)); const f32x2v qb = qe * Es;
                *(LAS unsigned*)(Qd + s * 136 + 2 * lane) = pack2(qe[0], qe[1]); *(LAS unsigned*)(Qb + s * 136 + 2 * lane) = pack2(qb[0], qb[1]);
                if (sub == 0) { const f32x2v k1 = ki * E1, k2 = ki * E2, k3 = ki * E3;
                    *(LAS unsigned*)(Kd + (0 + s) * 136 + 2 * lane) = pack2(ki[0], ki[1]); *(LAS unsigned*)(Kd + (16 + s) * 136 + 2 * lane) = pack2(k1[0], k1[1]);
                    *(LAS unsigned*)(Kd + (48 + s) * 136 + 2 * lane) = pack2(k2[0], k2[1]); *(LAS unsigned*)(Kd + (96 + s) * 136 + 2 * lane) = pack2(k3[0], k3[1]); }
                else if (sub == 1) { const f32x2v k2 = ki * D12, k3 = ki * D13;
                    *(LAS unsigned*)(Kd + (16 + s) * 136 + 2 * lane) = pack2(ki[0], ki[1]); *(LAS unsigned*)(Kd + (48 + s) * 136 + 2 * lane) = pack2(k2[0], k2[1]); *(LAS unsigned*)(Kd + (96 + s) * 136 + 2 * lane) = pack2(k3[0], k3[1]); }
                else if (sub == 2) { const f32x2v k3 = ki * D23;
                    *(LAS unsigned*)(Kd + (48 + s) * 136 + 2 * lane) = pack2(ki[0], ki[1]); *(LAS unsigned*)(Kd + (96 + s) * 136 + 2 * lane) = pack2(k3[0], k3[1]); }
                else { *(LAS unsigned*)(Kd + (96 + s) * 136 + 2 * lane) = pack2(ki[0], ki[1]); }
            }
        }
        lds_sync();
        bf16x8 sfr[4][4];
        { const bf16_t* st = states + ((size_t)bh * NCH + c) * 16384;
#pragma unroll
          for (int kk = 0; kk < 4; ++kk)
#pragma unroll
              for (int vi = 0; vi < 4; ++vi) sfr[kk][vi] = *(const bf16x8*)(st + (16 * (vb0 + vi) + fr) * 128 + 32 * kk + 8 * fq); }
        if (nit < NIT) EC_LOAD(nit)
        for (int bi = w; bi < 10; bi += 8) {
            const int i = bi >= 6 ? 3 : (bi >= 3 ? 2 : (bi >= 1 ? 1 : 0)); const int j = bi - (i * (i + 1)) / 2; const int offi = i == 0 ? 0 : (i == 1 ? 16 : (i == 2 ? 48 : 96));
            f32x4 acc = {0.f, 0.f, 0.f, 0.f};
#pragma unroll
            for (int kk = 0; kk < 4; ++kk) { const bf16x8 a = *(const LAS bf16x8*)(Qd + (16 * i + fr) * 136 + 32 * kk + 8 * fq); const bf16x8 bb = *(const LAS bf16x8*)(Kd + (offi + 16 * j + fr) * 136 + 32 * kk + 8 * fq); acc = mfma16(a, bb, acc); }
#pragma unroll
            for (int e = 0; e < 4; ++e) { const float v = (j == i && fr > 4 * fq + e) ? 0.f : acc[e]; Am[(16 * i + 4 * fq + e) * 72 + 16 * j + fr] = (bf16_t)f2bf(v); }
        }
        if (w >= 2) { const int zb = w - 2; const int zi = zb < 3 ? 0 : (zb < 5 ? 1 : 2); const int zj = zb < 3 ? zb + 1 : (zb < 5 ? zb - 1 : 3);
#pragma unroll
            for (int e = 0; e < 4; ++e) Am[(16 * zi + 4 * fq + e) * 72 + 16 * zj + fr] = (bf16_t)0; }
        lds_sync();
        {
            f32x4 acc[4];
#pragma unroll
            for (int vi = 0; vi < 4; ++vi) acc[vi] = (f32x4){0.f, 0.f, 0.f, 0.f};
#pragma unroll
            for (int kk = 0; kk < 4; ++kk) { const bf16x8 a = *(const LAS bf16x8*)(Qb + (16 * tb + fr) * 136 + 32 * kk + 8 * fq);
#pragma unroll
                for (int vi = 0; vi < 4; ++vi) acc[vi] = mfma16(a, sfr[kk][vi], acc[vi]); }
#pragma unroll
            for (int kk = 0; kk < 2; ++kk) { const bf16x8 a = *(const LAS bf16x8*)(Am + (16 * tb + fr) * 72 + 32 * kk + 8 * fq);
#pragma unroll
                for (int vi = 0; vi < 4; ++vi) { const bf16x8 bb = tr_frag(VT, 32 * kk, 16 * (vb0 + vi), fr, fq); acc[vi] = mfma16(a, bb, acc[vi]); } }
#pragma unroll
            for (int vi = 0; vi < 4; ++vi)
#pragma unroll
                for (int e = 0; e < 4; ++e) O[(16 * tb + 4 * fq + e) * 132 + 16 * (vb0 + vi) + fr] = acc[vi][e];
        }
        lds_sync();
        {
            f32x4 o[4]; float ss = 0.f;
#pragma unroll
            for (int i = 0; i < 4; ++i) { o[i] = *(const LAS f32x4*)(O + tn * 132 + v0 + 4 * i); ss += (o[i][0] * o[i][0] + o[i][1] * o[i][1]) + (o[i][2] * o[i][2] + o[i][3] * o[i][3]); }
            ss += __shfl_xor(ss, 1); ss += __shfl_xor(ss, 2); ss += __shfl_xor(ss, 4);
            const float rn = rsqrtf(ss * (1.0f / 128.0f) + EPS);
            if (nvalid) {
                const unsigned gw[8] = {g0.x, g0.y, g0.z, g0.w, g1.x, g1.y, g1.z, g1.w}; unsigned ow[8];
#pragma unroll
                for (int i = 0; i < 4; ++i) { const f32x4 gn = gnv[i];
                    const float y0 = o[i][0] * rn * gn[0] * silu(lo16(gw[2 * i])), y1 = o[i][1] * rn * gn[1] * silu(hi16(gw[2 * i])), y2 = o[i][2] * rn * gn[2] * silu(lo16(gw[2 * i + 1])), y3 = o[i][3] * rn * gn[3] * silu(hi16(gw[2 * i + 1]));
                    ow[2 * i] = pack2(y0, y1); ow[2 * i + 1] = pack2(y2, y3); }
                bf16_t* yp = Y + (size_t)nrow * DM + 256 + 128 * h + v0;
                *(u32x4*)yp = (u32x4){ow[0], ow[1], ow[2], ow[3]}; *(u32x4*)(yp + 8) = (u32x4){ow[4], ow[5], ow[6], ow[7]};
            }
        }
        lds_sync();
        it = nit;
    }
#undef EC_LOAD
#undef EC_SKIP
}

__device__ __forceinline__ void pool_items(const float* pw, const float* pscale, const bf16_t* P, bf16_t* Y, ldsp_t lds, int it_first, int it_stride, int it_end) {
    LAS float* U = (LAS float*)lds;
    LAS float* Wp = (LAS float*)(lds + 20224);
    LAS float* Mx = (LAS float*)(lds + 36608);
    const int tid = opaque_tid();
    const int NIT = it_end;
    u32x4 pv[2];
#define POOL_LOAD(IT) { const int g_ = (IT) & 3, bc_ = (IT) >> 2; const int b_ = bc_ == 512 ? 0 : bc_ >> 6, c_ = bc_ == 512 ? 0 : (bc_ & 63) + 1; \
        const int t0_ = c_ == 0 ? 0 : 16 + 64 * (c_ - 1), ntok_ = c_ == 0 ? 16 : 64; \
        _Pragma("unroll") for (int k = 0; k < 2; ++k) { const int idx = tid + 512 * k; const int r = idx >> 3, c8 = (idx & 7) * 8, ta = t0_ - 15 + r; pv[k] = (u32x4){0u, 0u, 0u, 0u}; \
            if (idx < 79 * 8 && ta >= 0 && r < 15 + ntok_) pv[k] = *(const u32x4*)(P + (size_t)row_of(b_, ta) * LDPE + 64 * g_ + c8); } }
    int it = it_first, cur_g = -1; f32x4 ps0 = {0.f, 0.f, 0.f, 0.f}, ps1 = {0.f, 0.f, 0.f, 0.f};
    if (it < NIT) POOL_LOAD(it)
    while (it < NIT) {
        const int g = it & 3, bc = it >> 2; const int b = bc == 512 ? 0 : bc >> 6, c = bc == 512 ? 0 : (bc & 63) + 1;
        const int t0 = c == 0 ? 0 : 16 + 64 * (c - 1), ntok = c == 0 ? 16 : 64, wsz = 2 << g;
#pragma unroll
        for (int k = 0; k < 2; ++k) { const int idx = tid + 512 * k; if (idx < 79 * 8) { const int r = idx >> 3, c8 = (idx & 7) * 8; const u32x4 v = pv[k];
            LAS float* up = U + r * 64 + c8; up[0] = lo16(v.x); up[1] = hi16(v.x); up[2] = lo16(v.y); up[3] = hi16(v.y); up[4] = lo16(v.z); up[5] = hi16(v.z); up[6] = lo16(v.w); up[7] = hi16(v.w); } }
        if (g != cur_g) { cur_g = g; ps0 = *(const f32x4*)(pscale + 64 * g + (tid & 7) * 8); ps1 = *(const f32x4*)(pscale + 64 * g + (tid & 7) * 8 + 4);
#pragma unroll
            for (int i = 0; i < 8; ++i) Wp[tid + 512 * i] = pw[g * 4096 + tid + 512 * i]; }
        lds_sync();
        const int nit = it + it_stride;
        if (nit < NIT) POOL_LOAD(nit)
#pragma unroll
        for (int i = 0; i < 8; ++i) { const int idx = tid + 512 * i, s = idx >> 6, ch = idx & 63, ta = t0 + s; float sum = 0.f;
            for (int j = 0; j < wsz; ++j) sum += U[(s + 15 - j) * 64 + ch];
            const int cnt = (ta + 1) < wsz ? (ta + 1) : wsz; Mx[s * 65 + ch] = sum * __builtin_amdgcn_rcpf((float)cnt) - U[(s + 15) * 64 + ch]; }
        lds_sync();
        { const int s = tid >> 3, d0 = (tid & 7) * 8; f32x4 a0 = {0.f, 0.f, 0.f, 0.f}, a1 = {0.f, 0.f, 0.f, 0.f};
          for (int ch = 0; ch < 64; ++ch) { const float m = Mx[s * 65 + ch]; a0 += m * *(const LAS f32x4*)(Wp + ch * 64 + d0); a1 += m * *(const LAS f32x4*)(Wp + ch * 64 + d0 + 4); }
          if (s < ntok) { a0 *= ps0; a1 *= ps1;
              u32x4 o; o.x = pack2(a0[0], a0[1]); o.y = pack2(a0[2], a0[3]); o.z = pack2(a1[0], a1[1]); o.w = pack2(a1[2], a1[3]);
              *(u32x4*)(Y + (size_t)row_of(b, t0 + s) * DM + 64 * g + d0) = o; } }
        lds_sync();
        it = nit;
    }
#undef POOL_LOAD
}

#undef CVG
#define CVG 3
__device__ void conv_items(const Params& p, const bf16_t* P, bf16_t* Y, ldsp_t lds) {
    LAS float* U = (LAS float*)lds;
    LAS float* Wc = (LAS float*)(lds + 48128);
    LAS float* Cv = (LAS float*)(lds + 64000);
    const int tid = opaque_tid(); const float* cw = p.in[18]; const float* cb = p.in[19]; const float* lg = p.in[20]; const float* lbb = p.in[21];
    const int NIT = 513 * 4;
    u32x4 pa[3], pb[3];
#define CONV_LOAD(IT) { const int g_ = (IT) & 3, bc_ = (IT) >> 2; const int b_ = bc_ == 512 ? 0 : bc_ >> 6, c_ = bc_ == 512 ? 0 : (bc_ & 63) + 1; \
        const int t0_ = c_ == 0 ? 0 : 16 + 64 * (c_ - 1), ntok_ = c_ == 0 ? 16 : 64; \
        _Pragma("unroll") for (int k = 0; k < 3; ++k) { const int idx = tid + 512 * k; const int r = idx >> 4, c8 = (idx & 15) * 8, ta = t0_ - 30 + r; pa[k] = (u32x4){0u, 0u, 0u, 0u}; pb[k] = (u32x4){0u, 0u, 0u, 0u}; \
            if (idx < 94 * 16 && ta >= 0 && r < 30 + ntok_) { const bf16_t* pr = P + (size_t)row_of(b_, ta) * LDPO + 128 * g_ + c8; pa[k] = *(const u32x4*)pr; pb[k] = *(const u32x4*)(pr + 512); } } }
    int it = blockIdx.x, cur_g = -1; float cbias = 0.f; f32x4 lgv[4], lbv[4];
#pragma unroll
    for (int i = 0; i < 4; ++i) { lgv[i] = (f32x4){0.f, 0.f, 0.f, 0.f}; lbv[i] = (f32x4){0.f, 0.f, 0.f, 0.f}; }
    if (it < NIT) CONV_LOAD(it)
    while (it < NIT) {
        const int g = it & 3, bc = it >> 2; const int b = bc == 512 ? 0 : bc >> 6, c = bc == 512 ? 0 : (bc & 63) + 1;
        const int t0 = c == 0 ? 0 : 16 + 64 * (c - 1), ntok = c == 0 ? 16 : 64;
#pragma unroll
        for (int k = 0; k < 3; ++k) { const int idx = tid + 512 * k; if (idx < 94 * 16) { const int r = idx >> 4, c8 = (idx & 15) * 8; const u32x4 av = pa[k], bv = pb[k];
            LAS float* up = U + r * 128 + c8;
            up[0] = lo16(av.x) * sigm(lo16(bv.x)); up[1] = hi16(av.x) * sigm(hi16(bv.x)); up[2] = lo16(av.y) * sigm(lo16(bv.y)); up[3] = hi16(av.y) * sigm(hi16(bv.y));
            up[4] = lo16(av.z) * sigm(lo16(bv.z)); up[5] = hi16(av.z) * sigm(hi16(bv.z)); up[6] = lo16(av.w) * sigm(lo16(bv.w)); up[7] = hi16(av.w) * sigm(hi16(bv.w)); } }
        if (g != cur_g) { cur_g = g; for (int idx = tid; idx < 31 * 128; idx += 512) Wc[idx] = cw[(idx >> 7) * 512 + 128 * g + (idx & 127)];
            cbias = cb[128 * g + (tid & 127)];
#pragma unroll
            for (int i = 0; i < 4; ++i) { lgv[i] = *(const f32x4*)(lg + 128 * g + (tid & 7) * 16 + 4 * i); lbv[i] = *(const f32x4*)(lbb + 128 * g + (tid & 7) * 16 + 4 * i); } }
        lds_sync();
        const int nit = it + (int)gridDim.x;
        if (nit < NIT) CONV_LOAD(nit)
        { const int ch = tid & 127, sb = tid >> 7; const float bias = cbias;
          float wr[31];
#pragma unroll
          for (int j = 0; j < 31; ++j) wr[j] = Wc[j * 128 + ch];
          float acc[16];
#pragma unroll
          for (int q = 0; q < 16; ++q) acc[q] = bias;
#pragma unroll
          for (int r = 0; r < 46; ++r) { const float uv = U[(16 * sb + r) * 128 + ch];
#pragma unroll
              for (int q = 0; q < 16; ++q) if (r - q >= 0 && r - q < 31) acc[q] += wr[r - q] * uv; }
#pragma unroll
          for (int q = 0; q < 16; ++q) Cv[(16 * sb + q) * 128 + ch] = acc[q]; }
        lds_sync();
        { const int t = tid >> 3, c0 = (tid & 7) * 16; f32x4 v[4]; float sm = 0.f;
#pragma unroll
          for (int i = 0; i < 4; ++i) { v[i] = *(const LAS f32x4*)(Cv + t * 128 + c0 + 4 * i); sm += (v[i][0] + v[i][1]) + (v[i][2] + v[i][3]); }
          sm += __shfl_xor(sm, 1); sm += __shfl_xor(sm, 2); sm += __shfl_xor(sm, 4);
          const float mu = sm * (1.0f / 128.0f); float sq = 0.f;
#pragma unroll
          for (int i = 0; i < 4; ++i) { v[i] -= mu; sq += (v[i][0] * v[i][0] + v[i][1] * v[i][1]) + (v[i][2] * v[i][2] + v[i][3] * v[i][3]); }
          sq += __shfl_xor(sq, 1); sq += __shfl_xor(sq, 2); sq += __shfl_xor(sq, 4);
          const float rs = rsqrtf(sq * (1.0f / 128.0f) + EPS);
          if (t < ntok) { unsigned ow[8];
#pragma unroll
              for (int i = 0; i < 4; ++i) { const f32x4 un = v[i] * rs * lgv[i] + lbv[i];
                  ow[2 * i] = pack2(silu(un[0]), silu(un[1])); ow[2 * i + 1] = pack2(silu(un[2]), silu(un[3])); }
              bf16_t* yp = Y + (size_t)row_of(b, t0 + t) * DM + 128 * g + c0;
              *(u32x4*)yp = (u32x4){ow[0], ow[1], ow[2], ow[3]}; *(u32x4*)(yp + 8) = (u32x4){ow[4], ow[5], ow[6], ow[7]}; } }
        lds_sync();
        it = nit;
    }
#undef CONV_LOAD
}

__device__ void lru_items(const Params& p, const bf16_t* P, float* hloc, float* cpo, float* aagg, float* bagg, ldsp_t lds) {
    LAS float* XB = (LAS float*)lds;
    LAS float* Uc = (LAS float*)(lds + 17152);
    LAS bf16_t* Ub = (LAS bf16_t*)(lds + 33536);
    LAS bf16_t* WaT = (LAS bf16_t*)(lds + 42752);
    LAS bf16_t* WxT = (LAS bf16_t*)(lds + 51968);
    LAS float* Aa = (LAS float*)(lds + 61184);
    LAS float* Bt = (LAS float*)(lds + 77568);
    LAS float* Ag = (LAS float*)(lds + 93952);
    LAS float* Bg = (LAS float*)(lds + 96000);
    const int tid = opaque_tid(), lane = tid & 63, w = tid >> 6, fr = lane & 15, fq = lane >> 4;
    const float* cw = p.in[22]; const float* cb = p.in[23]; const float* wa = p.in[24]; const float* ba = p.in[25]; const float* wx = p.in[26]; const float* bx = p.in[27]; const float* lam = p.in[28];
    int cur_hh = -1; float lcb = 0.f, lcw[4] = {0.f, 0.f, 0.f, 0.f}, lba[2] = {0.f, 0.f}, lbx[2] = {0.f, 0.f}, lsp[2] = {0.f, 0.f};
    const int NIT = 8 * NCH * 8;
    u32x4 px[2];
#define LRU_LOAD(IT) { const int hh_ = (IT) & 7, bc_ = (IT) >> 3, b_ = bc_ / NCH, c_ = bc_ % NCH; const int t0_ = c_ == 0 ? 0 : 16 + 64 * (c_ - 1), ntok_ = c_ == 0 ? 16 : 64; \
        _Pragma("unroll") for (int k = 0; k < 2; ++k) { const int idx = tid + 512 * k; const int r = idx >> 3, c8 = (idx & 7) * 8, ta = t0_ - 3 + r; px[k] = (u32x4){0u, 0u, 0u, 0u}; \
            if (idx < 67 * 8 && ta >= 0 && r < 3 + ntok_) px[k] = *(const u32x4*)(P + (size_t)row_of(b_, ta) * LDPO + 1024 + 64 * hh_ + c8); } }
    int it = blockIdx.x;
    if (it < NIT) LRU_LOAD(it)
    while (it < NIT) {
        const int hh = it & 7, bc = it >> 3, b = bc / NCH, c = bc % NCH;
        const int t0 = c == 0 ? 0 : 16 + 64 * (c - 1), ntok = c == 0 ? 16 : 64;
#pragma unroll
        for (int k = 0; k < 2; ++k) { const int idx = tid + 512 * k; if (idx < 67 * 8) { const int r = idx >> 3, c8 = (idx & 7) * 8; const u32x4 v = px[k];
            LAS float* up = XB + r * 64 + c8; up[0] = lo16(v.x); up[1] = hi16(v.x); up[2] = lo16(v.y); up[3] = hi16(v.y); up[4] = lo16(v.z); up[5] = hi16(v.z); up[6] = lo16(v.w); up[7] = hi16(v.w); } }
        if (hh != cur_hh) {
            cur_hh = hh;
            { const int chq = tid & 63; lcb = cb[64 * hh + chq];
#pragma unroll
              for (int j = 0; j < 4; ++j) lcw[j] = cw[j * 512 + 64 * hh + chq];
#pragma unroll
              for (int j = 0; j < 2; ++j) { const int o = 16 * (2 * (w & 1) + j) + fr; lba[j] = ba[64 * hh + o]; lbx[j] = bx[64 * hh + o]; lsp[j] = log1pf(__expf(-lam[64 * hh + o])); } }
#pragma unroll
            for (int i = 0; i < 8; ++i) { const int idx = tid + 512 * i, ii = idx >> 6, o = idx & 63; WaT[o * 72 + ii] = (bf16_t)f2bf(wa[hh * 4096 + idx]); WxT[o * 72 + ii] = (bf16_t)f2bf(wx[hh * 4096 + idx]); }
        }
        lds_sync();
        const int nit = it + (int)gridDim.x;
        if (nit < NIT) LRU_LOAD(nit)
#pragma unroll
        for (int i = 0; i < 8; ++i) { const int idx = tid + 512 * i, s = idx >> 6, ch = idx & 63; float u = lcb;
#pragma unroll
            for (int j = 0; j < 4; ++j) u += lcw[j] * XB[(s + j) * 64 + ch];
            Uc[idx] = u; Ub[s * 72 + ch] = (bf16_t)f2bf(u); }
        lds_sync();
        {
            const int sbk = w >> 1, ob0 = 2 * (w & 1);
            f32x4 accA[2], accX[2];
#pragma unroll
            for (int j = 0; j < 2; ++j) { accA[j] = (f32x4){0.f, 0.f, 0.f, 0.f}; accX[j] = (f32x4){0.f, 0.f, 0.f, 0.f}; }
#pragma unroll
            for (int kk = 0; kk < 2; ++kk) { const bf16x8 a = *(const LAS bf16x8*)(Ub + (16 * sbk + fr) * 72 + 32 * kk + 8 * fq);
#pragma unroll
                for (int j = 0; j < 2; ++j) { const bf16x8 b1 = *(const LAS bf16x8*)(WaT + (16 * (ob0 + j) + fr) * 72 + 32 * kk + 8 * fq), b2 = *(const LAS bf16x8*)(WxT + (16 * (ob0 + j) + fr) * 72 + 32 * kk + 8 * fq);
                    accA[j] = mfma16(a, b1, accA[j]); accX[j] = mfma16(a, b2, accX[j]); } }
#pragma unroll
            for (int j = 0; j < 2; ++j) { const int o = 16 * (ob0 + j) + fr; const float bao = lba[j], bxo = lbx[j]; const float sp = lsp[j];
#pragma unroll
                for (int e = 0; e < 4; ++e) { const int s = 16 * sbk + 4 * fq + e; const bool valid = s < ntok; const bool first = (t0 + s) == 0;
                    const float rr = sigm(accA[j][e] + bao), ig = sigm(accX[j][e] + bxo); const float la = -8.0f * rr * sp; const float a = __expf(la); const float x2 = 2.0f * la; const float m2 = x2 > -0.05f ? -x2 * (1.0f + x2 * (0.5f + x2 * (0.16666667f + x2 * 0.041666668f))) : 1.0f - a * a; const float mult = __builtin_amdgcn_sqrtf(m2);
                    const float bt = (first ? 1.0f : mult) * ig * Uc[s * 64 + o];
                    Aa[s * 64 + o] = valid ? a : 1.0f; Bt[s * 64 + o] = valid ? bt : 0.f; } }
        }
        lds_sync();
        const int ch = tid & 63, sb = tid >> 6;
        { float cp = 1.0f, hv = 0.f;
#pragma unroll
          for (int q = 0; q < 8; ++q) { const int s = 8 * sb + q; const float a = Aa[s * 64 + ch], bt = Bt[s * 64 + ch]; hv = a * hv + bt; cp *= a; Aa[s * 64 + ch] = cp; Bt[s * 64 + ch] = hv; }
          Ag[sb * 64 + ch] = cp; Bg[sb * 64 + ch] = hv; }
        lds_sync();
        { float carry = 0.f, cpin = 1.0f;
          for (int q = 0; q < sb; ++q) { const float a = Ag[q * 64 + ch]; carry = a * carry + Bg[q * 64 + ch]; cpin *= a; }
          float hl = 0.f, cf = 1.0f;
#pragma unroll
          for (int q = 0; q < 8; ++q) { const int s = 8 * sb + q; hl = Bt[s * 64 + ch] + Aa[s * 64 + ch] * carry; cf = Aa[s * 64 + ch] * cpin;
              if (s < ntok && (c > 0 || b == 0)) { const size_t o = (size_t)row_of(b, t0 + s) * 512 + 64 * hh + ch; hloc[o] = hl; cpo[o] = cf; } }
          if (sb == 7) { aagg[((size_t)b * NCH + c) * 512 + 64 * hh + ch] = cf; bagg[((size_t)b * NCH + c) * 512 + 64 * hh + ch] = hl; } }
        lds_sync();
        it = nit;
    }
#undef LRU_LOAD
}

__device__ void lru_combine(const bf16_t* P, const float* hloc, const float* cpo, const float* aagg, const float* bagg, bf16_t* Y, ldsp_t lds) {
    LAS float* Cr = (LAS float*)lds;
    const int tid = opaque_tid(), lane = tid & 63, w = tid >> 6;
    for (int bc = blockIdx.x; bc < 513; bc += gridDim.x) {
        const int b = bc == 512 ? 0 : bc >> 6, c = bc == 512 ? 0 : (bc & 63) + 1;
        const int t0 = c == 0 ? 0 : 16 + 64 * (c - 1), ntok = c == 0 ? 16 : 64;
        { float carry = 0.f; const float* ap = aagg + (size_t)b * NCH * 512 + tid; const float* bp = bagg + (size_t)b * NCH * 512 + tid;
          int q = 0;
          for (; q + 8 <= c; q += 8) { float a[8], bb[8];
#pragma unroll
              for (int j = 0; j < 8; ++j) { a[j] = ap[(q + j) * 512]; bb[j] = bp[(q + j) * 512]; }
#pragma unroll
              for (int j = 0; j < 8; ++j) carry = a[j] * carry + bb[j]; }
          for (; q < c; ++q) carry = ap[q * 512] * carry + bp[q * 512];
          Cr[tid] = carry; }
        lds_sync();
        const f32x4 c0 = *(const LAS f32x4*)(Cr + lane * 8), c1 = *(const LAS f32x4*)(Cr + lane * 8 + 4);
        for (int s0 = w; s0 < ntok; s0 += 32) {
            f32x4 h0[4], h1[4], p0[4], p1[4]; u32x4 g[4];
#pragma unroll
            for (int k = 0; k < 4; ++k) { const int s = s0 + 8 * k; if (s < ntok) { const size_t row = (size_t)row_of(b, t0 + s);
                h0[k] = *(const f32x4*)(hloc + row * 512 + lane * 8); h1[k] = *(const f32x4*)(hloc + row * 512 + lane * 8 + 4);
                p0[k] = *(const f32x4*)(cpo + row * 512 + lane * 8); p1[k] = *(const f32x4*)(cpo + row * 512 + lane * 8 + 4);
                g[k] = *(const u32x4*)(P + row * LDPO + 1536 + lane * 8); } }
            asm volatile("" ::: "memory");
#pragma unroll
            for (int k = 0; k < 4; ++k) { const int s = s0 + 8 * k; if (s < ntok) { const size_t row = (size_t)row_of(b, t0 + s);
                const f32x4 v0 = h0[k] + p0[k] * c0, v1 = h1[k] + p1[k] * c1; u32x4 o;
                o.x = pack2(gelu_tanh(lo16(g[k].x)) * v0[0], gelu_tanh(hi16(g[k].x)) * v0[1]); o.y = pack2(gelu_tanh(lo16(g[k].y)) * v0[2], gelu_tanh(hi16(g[k].y)) * v0[3]);
                o.z = pack2(gelu_tanh(lo16(g[k].z)) * v1[0], gelu_tanh(hi16(g[k].z)) * v1[1]); o.w = pack2(gelu_tanh(lo16(g[k].w)) * v1[2], gelu_tanh(hi16(g[k].w)) * v1[3]);
                *(u32x4*)(Y + row * DM + 512 + lane * 8) = o; } }
        }
        lds_sync();
    }
}

__device__ void final_norm(float* H, const float* __restrict__ fn) {
    const int tid_ = opaque_tid(); const int lane = tid_ & 63, gw = blockIdx.x * 8 + (tid_ >> 6), nw = gridDim.x * 8;
    f32x4 g[4];
#pragma unroll
    for (int i = 0; i < 4; ++i) g[i] = *(const f32x4*)(fn + i * 256 + lane * 4);
    f32x4 v[4], nv[4];
    int row = gw;
    if (row < MMAIN) {
#pragma unroll
        for (int i = 0; i < 4; ++i) v[i] = *(const f32x4*)(H + (size_t)row * DM + i * 256 + lane * 4); }
    while (row < MMAIN) {
        const int nrow = row + nw;
        if (nrow < MMAIN) {
#pragma unroll
            for (int i = 0; i < 4; ++i) nv[i] = *(const f32x4*)(H + (size_t)nrow * DM + i * 256 + lane * 4); }
        asm volatile("" ::: "memory");
        float ss = 0.f;
#pragma unroll
        for (int i = 0; i < 4; ++i) ss += (v[i][0] * v[i][0] + v[i][1] * v[i][1]) + (v[i][2] * v[i][2] + v[i][3] * v[i][3]);
#pragma unroll
        for (int o = 32; o >= 1; o >>= 1) ss += __shfl_xor(ss, o);
        const float rs = rsqrtf(ss * (1.0f / 1024.0f) + EPS);
#pragma unroll
        for (int i = 0; i < 4; ++i) *(f32x4*)(H + (size_t)row * DM + i * 256 + lane * 4) = v[i] * rs * g[i];
#pragma unroll
        for (int i = 0; i < 4; ++i) v[i] = nv[i];
        row = nrow;
    }
}

#define XB_TMO      128
#define XB_XCNT(j)  (256  + 64 * (j))
#define XB_XSUB(j)  (1280 + 64 * (j))
#define XB_XGEN(j)  (2304 + 64 * (j))
#define XB_TOP      3328
#define XB_TOPGEN   3392
#define XCD_BAR_WORDS 3456
#define XB_SPIN_CAP (1u << 18)

__device__ __forceinline__ unsigned xb_ld(unsigned* p)              { return __hip_atomic_load(p, __ATOMIC_RELAXED, __HIP_MEMORY_SCOPE_AGENT); }
__device__ __forceinline__ unsigned xb_add(unsigned* p, unsigned v) { return __hip_atomic_fetch_add(p, v, __ATOMIC_RELAXED, __HIP_MEMORY_SCOPE_AGENT); }
__device__ __forceinline__ unsigned xb_xcc_id() { return (unsigned)__builtin_amdgcn_s_getreg((3 << 11) | 20) & 0xFu; }
#define XB_SPIN(cond, bar) do { unsigned _sp = 0; while (cond) { __builtin_amdgcn_s_sleep(1); \
    if ((++_sp & 255u) == 0u) { if (xb_ld(&(bar)[XB_TMO])) break; if (_sp > XB_SPIN_CAP) { atomicAdd(&(bar)[XB_TMO], 1u); break; } } } } while (0)

struct XcdBarrier {
    unsigned* bar; unsigned x;
    volatile LAS unsigned* st;
};

__device__ __forceinline__ XcdBarrier xcd_barrier_post(unsigned* bar, volatile LAS unsigned* st) {
    XcdBarrier b; b.bar = bar; b.x = xb_xcc_id(); b.st = st;
    if (threadIdx.x == 0) { const unsigned slot = xb_add(&bar[XB_XCNT(b.x)], 1u); st[2] = slot * 8u + b.x; }
    return b;
}
__device__ __forceinline__ void xcd_barrier_complete(unsigned* bar, unsigned x, unsigned& nloc, unsigned& nx) {
    const unsigned G = gridDim.x * gridDim.y * gridDim.z;
    unsigned sum, cnt, mine, sp = 0u;
    for (;;) {
        sum = 0u; cnt = 0u; mine = 0u;
#pragma unroll
        for (unsigned j = 0; j < 16; ++j) { const unsigned c = xb_ld(&bar[XB_XCNT(j)]); sum += c; cnt += (c > 0u) ? 1u : 0u; mine = (j == x) ? c : mine; }
        if (sum == G) break;
        __builtin_amdgcn_s_sleep(1);
        if ((++sp & 255u) == 0u) { if (xb_ld(&bar[XB_TMO])) break; if (sp > XB_SPIN_CAP) { atomicAdd(&bar[XB_TMO], 1u); break; } }
    }
    nloc = mine > 0u ? mine : 1u; nx = cnt > 0u ? cnt : 1u;
}

__device__ __noinline__ void xcd_barrier(const XcdBarrier b) {
    asm volatile("s_waitcnt vmcnt(0)" ::: "memory");
    __syncthreads();
    if (threadIdx.x == 0) {
        unsigned* bar = b.bar;
        __builtin_amdgcn_s_waitcnt(0);
        unsigned nloc = b.st[0], nx = b.st[1];
        if (nloc == 0u) { xcd_barrier_complete(bar, b.x, nloc, nx); b.st[0] = nloc; b.st[1] = nx; }
        const unsigned old = xb_add(&bar[XB_XSUB(b.x)], 1u);
        const unsigned gen = old / nloc;
        if (old + 1u == (gen + 1u) * nloc) {
            __builtin_amdgcn_fence(__ATOMIC_RELEASE, "agent");
            asm volatile("s_waitcnt vmcnt(0)" ::: "memory");
            const unsigned og = xb_add(&bar[XB_TOP], 1u);
            const unsigned tg = og / nx;
            if (og + 1u == (tg + 1u) * nx) xb_add(&bar[XB_TOPGEN], 1u);
            else XB_SPIN(xb_ld(&bar[XB_TOPGEN]) == tg, bar);
            __builtin_amdgcn_fence(__ATOMIC_ACQUIRE, "agent");
            xb_add(&bar[XB_XGEN(b.x)], 1u);
            asm volatile("s_waitcnt vmcnt(0)" ::: "memory");
        } else {
            XB_SPIN(xb_ld(&bar[XB_XGEN(b.x)]) == gen, bar);
            __builtin_amdgcn_fence(__ATOMIC_ACQUIRE, "agent");
            asm volatile("s_waitcnt vmcnt(0)" ::: "memory");
        }
    }
    __syncthreads();
}


#ifdef PROBE_GEMM_L2
struct NullEpi { static constexpr bool PERM = false, AFTER_DRAIN = false; float* sink;
    __device__ __forceinline__ void operator()(const f32x4 (&acc)[2][2][4][2], const pg8::Unit& u, int wr, int wc, int fr, int fq, int, ldsp_t) const {
        float s = 0.f;
#pragma unroll
        for (int ai = 0; ai < 2; ++ai)
#pragma unroll
            for (int bj = 0; bj < 2; ++bj)
#pragma unroll
                for (int m = 0; m < 4; ++m)
#pragma unroll
                    for (int n = 0; n < 2; ++n) s += acc[ai][bj][m][n][0] + acc[ai][bj][m][n][1] + acc[ai][bj][m][n][2] + acc[ai][bj][m][n][3];
        if (s == 123.456f) sink[0] = s; } };
struct ProbeOrder : pg8::StaticOrder { __device__ bool next(int i, pg8::Unit& u) const { const bool ok = pg8::StaticOrder::next(i, u); u.pm = 0; u.pn = 0; return ok; } };
#endif
__device__ __noinline__ void rstd_table(ldsp_t lds, int N, int vcu, const float* rowss) {
    pg8::StaticOrder S; S.init(MMAIN, N, (int)gridDim.x, vcu);
    LAS float* tab = (LAS float*)(lds + RSTD_TAB_OFF);
    const int tid = opaque_tid(); pg8::Unit u;
    for (int i0 = 0; i0 < 12; i0 += 2) { const int i = i0 + (tid >> 8);
        if (S.next(i, u)) { const float* rp = rowss + (size_t)(u.pm * 256 + (tid & 255)) * 16;
            const f32x4 a = *(const f32x4*)rp, b = *(const f32x4*)(rp + 4), c = *(const f32x4*)(rp + 8), d = *(const f32x4*)(rp + 12);
            const f32x4 s4 = (a + b) + (c + d); tab[i * 256 + (tid & 255)] = rsqrtf(((s4[0] + s4[1]) + (s4[2] + s4[3])) * (1.0f / 1024.0f) + EPS); } }
    __syncthreads();
}
template <class Epi> __device__ __forceinline__ void run_gemm(ldsp_t lds, const bf16_t* A, const bf16_t* Bt, int N, int K, const Epi& E, int vcu) {
    pg8::Gemm g{A, Bt, MMAIN, N, K}; pg8::StaticOrder S; S.init(MMAIN, N, (int)gridDim.x, vcu);
    pg8::gemm_phase<Epi, pg8::StaticOrder>(lds, g, S, E);
}

__global__ void __launch_bounds__(512, 2) fwd_megakernel(Params p) {
    extern __shared__ __attribute__((aligned(16))) unsigned char lds_raw[];
    cg::grid_group grid = cg::this_grid();
    ldsp_t lds = (ldsp_t)lds_raw;
    unsigned char* ws = p.ws;
    volatile LAS unsigned* xst = (volatile LAS unsigned*)(lds + 155136);
    if (threadIdx.x < 4) xst[threadIdx.x] = 0u;
    __syncthreads();
    XcdBarrier xb = xcd_barrier_post((unsigned*)(ws + OFF_BAR), xst);
    bf16_t* X1 = (bf16_t*)(ws + OFF_X1); bf16_t* Y = (bf16_t*)(ws + OFF_Y); bf16_t* BIG = (bf16_t*)(ws + OFF_BIG); unsigned char* R = ws + OFF_R;
    float* hmeta = (float*)(ws + OFF_HMETA); float* rowss = (float*)(ws + OFF_ROWSS); float* dec = (float*)(ws + OFF_DEC); float* aagg = (float*)(ws + OFF_AAGG); float* bagg = (float*)(ws + OFF_BAGG);
#ifndef REP_UP
#define REP_UP 1
#endif
#ifndef REP_DOWN
#define REP_DOWN 0
#endif
#ifndef REP_SYNC
#define REP_SYNC 1
#endif
#if REP_SYNC > 1
#define GSYNC() { xcd_barrier(xb); xcd_barrier(xb); }
#else
#define GSYNC() { xcd_barrier(xb); }
#endif
#define GEMM_UP1(WOFF) { meta_gemm<0, 4>(lds, X1 + (size_t)MMAIN * DM, (const bf16_t*)(WOFF), 176, hmeta, BIG, DFF, 0.f); rstd_table(lds, 5632, vcu, rowss); EpiUp eu{BIG, rowss}; run_gemm<EpiUp>(lds, X1, (const bf16_t*)(WOFF), 5632, DM, eu, vcu); }
#if REP_UP > 1
#define GEMM_UP(WOFF) GEMM_UP1(WOFF) GEMM_UP1(WOFF) GSYNC();
#else
#define GEMM_UP(WOFF) GEMM_UP1(WOFF) GSYNC();
#endif
#if REP_DOWN > 0
#define GEMM_DOWN2(WOFF) { EpiRes e2{p.out, p.out, X1, rowss, 0.0f}; run_gemm<EpiRes>(lds, BIG, (const bf16_t*)(WOFF), DM, DFF, e2, vcu); }
#else
#define GEMM_DOWN2(WOFF)
#endif
#define GEMM_DOWN(WOFF, BASEMAIN) { meta_gemm<2, 11>(lds, BIG + (size_t)MMAIN * DFF, (const bf16_t*)(WOFF), 64, hmeta, X1, DM, 0.5f); EpiRes er{BASEMAIN, p.out, X1, rowss, 0.5f}; run_gemm<EpiRes>(lds, BIG, (const bf16_t*)(WOFF), DM, DFF, er, vcu); } GEMM_DOWN2(WOFF) GSYNC();
#define GEMM_OUT(WOFF) { meta_gemm<2, 4>(lds, Y + (size_t)MMAIN * DM, (const bf16_t*)(WOFF), 64, hmeta, X1, DM, 1.0f); EpiRes er{p.out, p.out, X1, rowss, 1.0f}; run_gemm<EpiRes>(lds, Y, (const bf16_t*)(WOFF), DM, DM, er, vcu); } GSYNC();
    conv_ffn(p, 0, 0, (bf16_t*)(ws + WA_UP0), (bf16_t*)(ws + WA_DN0), lds); conv_ffn(p, 0, 1, (bf16_t*)(ws + WA_UP1), (bf16_t*)(ws + WA_DN1), lds);
    convT_job(p.in[11], DM, 3328, p.in[6], (bf16_t*)(ws + WA_INE), -1, lds); convT_job(p.in[16], DM, DM, nullptr, (bf16_t*)(ws + WA_OUTE), -1, lds);
    prep_rows(p, X1, rowss, hmeta);
#ifdef REP_PREP
    prep_rows(p, X1, rowss, hmeta);
#endif
#ifdef REP_P0
    conv_ffn(p, 0, 0, (bf16_t*)(ws + WA_UP0), (bf16_t*)(ws + WA_DN0), lds); conv_ffn(p, 0, 1, (bf16_t*)(ws + WA_UP1), (bf16_t*)(ws + WA_DN1), lds);
    convT_job(p.in[11], DM, 3328, p.in[6], (bf16_t*)(ws + WA_INE), -1, lds); convT_job(p.in[16], DM, DM, nullptr, (bf16_t*)(ws + WA_OUTE), -1, lds);
    prep_rows(p, X1, rowss, hmeta);
#endif
    if (p.nrep == 0x7fffffff) grid.sync();
    GSYNC();
    int vcu = (int)blockIdx.x;
    { unsigned cnts[8];
#pragma unroll
      for (unsigned j = 0; j < 8; ++j) cnts[j] = xb_ld((unsigned*)(ws + OFF_BAR) + XB_XCNT(j));
      bool even = (gridDim.x % 8u) == 0u;
#pragma unroll
      for (unsigned j = 0; j < 8; ++j) even = even & (cnts[j] == gridDim.x / 8u);
      if (even) vcu = (int)xst[2]; }

    GEMM_UP(ws + WA_UP0)
#ifdef PROBE_GEMM_L2
    { pg8::Gemm g{X1, (const bf16_t*)(ws + WA_UP0), MMAIN, 5632, DM}; ProbeOrder S; S.init(MMAIN, 5632, (int)gridDim.x, vcu); NullEpi ne{hmeta}; pg8::gemm_phase<NullEpi, ProbeOrder>(lds, g, S, ne); }
    GSYNC();
#endif
    GEMM_DOWN(ws + WA_DN0, p.in[0])
    { meta_gemm<1, 4>(lds, X1 + (size_t)MMAIN * DM, (const bf16_t*)(ws + WA_INE), 208, hmeta, BIG, LDPE, 0.f); rstd_table(lds, 3328, vcu, rowss); EpiIn ei{BIG, LDPE, rowss}; run_gemm<EpiIn>(lds, X1, (const bf16_t*)(ws + WA_INE), 3328, DM, ei, vcu); } GSYNC();
    hg_phaseA(p, BIG, (bf16_t*)R, dec, lds); pool_items(p.in[12], p.in[13], BIG, Y, lds, (int)blockIdx.x, (int)gridDim.x, POOL_SPLIT);
#ifdef REP_EA
    hg_phaseA(p, BIG, (bf16_t*)R, dec, lds); pool_items(p.in[12], p.in[13], BIG, Y, lds, (int)blockIdx.x, (int)gridDim.x, POOL_SPLIT);
#endif
    GSYNC();
    hg_phaseB((bf16_t*)R, dec);
    {
        const bool g256 = gridDim.x == 256u;
        const int pf = g256 ? (blockIdx.x >= 192u ? POOL_SPLIT + (int)blockIdx.x - 192 : 513 * 4) : POOL_SPLIT + (int)blockIdx.x, ps = g256 ? 64 : (int)gridDim.x;
        pool_items(p.in[12], p.in[13], BIG, Y, lds, pf, ps, 513 * 4);
    }
    GSYNC();
#ifdef REP_EC
    for (int rep_ = 0; rep_ < p.nrep; ++rep_)
#endif
    hg_phaseC(p, BIG, (const bf16_t*)R, Y, lds);
    GSYNC();
    conv_ffn(p, 1, 0, (bf16_t*)(R + WB_UP2), (bf16_t*)(R + WB_DN2), lds); conv_ffn(p, 1, 1, (bf16_t*)(R + WB_UP3), (bf16_t*)(R + WB_DN3), lds);
    convT_job(p.in[17], DM, 2048, p.in[6] + DM, (bf16_t*)(R + WB_INO), -1, lds); convT_job(p.in[29], DM, DM, nullptr, (bf16_t*)(R + WB_OUTO), -1, lds);
#ifdef REP_W1
    conv_ffn(p, 1, 0, (bf16_t*)(R + WB_UP2), (bf16_t*)(R + WB_DN2), lds); conv_ffn(p, 1, 1, (bf16_t*)(R + WB_UP3), (bf16_t*)(R + WB_DN3), lds);
    convT_job(p.in[17], DM, 2048, p.in[6] + DM, (bf16_t*)(R + WB_INO), -1, lds); convT_job(p.in[29], DM, DM, nullptr, (bf16_t*)(R + WB_OUTO), -1, lds);
#endif
    GEMM_OUT(ws + WA_OUTE)
    GEMM_UP(ws + WA_UP1) GEMM_DOWN(ws + WA_DN1, p.out)
    GEMM_UP(R + WB_UP2) GEMM_DOWN(R + WB_DN2, p.out)
    { meta_gemm<1, 4>(lds, X1 + (size_t)MMAIN * DM, (const bf16_t*)(R + WB_INO), 128, hmeta, BIG, LDPO, 0.f); rstd_table(lds, 2048, vcu, rowss); EpiIn ei{BIG, LDPO, rowss}; run_gemm<EpiIn>(lds, X1, (const bf16_t*)(R + WB_INO), 2048, DM, ei, vcu); } GSYNC();
    conv_items(p, BIG, Y, lds); lru_items(p, BIG, (float*)X1, (float*)(ws + OFF_CP), aagg, bagg, lds);
#ifdef REP_OA
    conv_items(p, BIG, Y, lds); lru_items(p, BIG, (float*)X1, (float*)(ws + OFF_CP), aagg, bagg, lds);
#endif
    GSYNC();
    lru_combine(BIG, (const float*)X1, (const float*)(ws + OFF_CP), aagg, bagg, Y, lds); GSYNC();
    GEMM_OUT(R + WB_OUTO)
    GEMM_UP(R + WB_UP3)
    { meta_gemm<2, 11>(lds, BIG + (size_t)MMAIN * DFF, (const bf16_t*)(R + WB_DN3), 64, hmeta, X1, DM, 0.5f);
      EpiFinal ef{p.out, p.out, rowss, (unsigned*)(ws + OFF_FCNT), p.in[30], 0.5f}; run_gemm<EpiFinal>(lds, BIG, (const bf16_t*)(R + WB_DN3), DM, DFF, ef, vcu); }
}

extern "C" void kernel_launch(void* const* d_in, const int* in_sizes, int n_in, void* d_out, int out_size, void* d_ws, size_t ws_size, hipStream_t stream) {
    static int grid_blocks = 0;
    if (!grid_blocks) {
        int dev = 0, cus = 0, per_cu = 0;
        (void)hipGetDevice(&dev);
        (void)hipDeviceGetAttribute(&cus, hipDeviceAttributeMultiprocessorCount, dev);
        (void)hipFuncSetAttribute((const void*)fwd_megakernel, hipFuncAttributeMaxDynamicSharedMemorySize, LDS_BYTES);
        (void)hipOccupancyMaxActiveBlocksPerMultiprocessor(&per_cu, (const void*)fwd_megakernel, 512, LDS_BYTES);
        grid_blocks = cus > 0 ? cus : 256;
        fprintf(stderr, "kernel_launch: cus=%d per_cu=%d grid=%d ws_size=%zu need=%zu n_in=%d\n", cus, per_cu, grid_blocks, ws_size, (size_t)WS_END, n_in);
        if (ws_size < OFF_BAR + 32768 || n_in != 31) { fprintf(stderr, "kernel_launch: workspace too small or wrong input count; nothing launched\n"); grid_blocks = -1; }
    }
    if (grid_blocks < 0) return;
    Params p{};
    for (int i = 0; i < 31; ++i) p.in[i] = (const float*)d_in[i];
    p.out = (float*)d_out; p.ws = (unsigned char*)d_ws; p.nrep = 2; p.pad = 0;
    (void)hipMemsetAsync((unsigned char*)d_ws + OFF_BAR, 0, 32768, stream);
    void* args[] = {&p};
    hipError_t e = hipLaunchCooperativeKernel((const void*)fwd_megakernel, dim3(grid_blocks), dim3(512), args, LDS_BYTES, stream);
    if (e != hipSuccess) fprintf(stderr, "cooperative launch failed: %s (grid %d)\n", hipGetErrorString(e), grid_blocks);
}
```

```cpp
#include <hip/hip_runtime.h>
#include <hip/hip_cooperative_groups.h>
#include <cstdio>
namespace cg = cooperative_groups;
namespace pg8 {
#define PG8_LAS __attribute__((address_space(3)))
typedef unsigned short bf16_t;
typedef short bf16x8 __attribute__((ext_vector_type(8)));
typedef float f32x4 __attribute__((ext_vector_type(4)));
typedef unsigned u32x4 __attribute__((ext_vector_type(4)));
constexpr int BM = 256, BK = 64, HALF = 128, HTB = HALF * BK * 2  , STAGE_BYTES = 8 * HTB, NXCD = 8, WGM = 8;

__host__ __device__ __forceinline__ int lds_byte(int r, int c) { const int st = (r >> 4) * 2 + (c >> 5), rr = r & 15, cc = c & 31, ob = rr * 64 + cc * 2; return st * 1024 + (ob ^ (((ob >> 9) & 1) << 5)); }
__host__ __device__ __forceinline__ void stage_rc(int b, int& R, int& C) { const int st = b / 1024, sb = b % 1024, swz = sb ^ (((sb >> 9) & 1) << 5); R = (st >> 1) * 16 + swz / 64; C = (st & 1) * 32 + (swz % 64) / 2; }
__host__ __device__ __forceinline__ int perm32(int rho) { const int n = rho >> 4, i = rho & 15; return 8 * (i >> 2) + 4 * n + (i & 3); }

struct Unit { int pm, pn; };
struct Gemm { const bf16_t* A; const bf16_t* Bt; int M, N, K; };

struct StaticOrder {
    int nM, nN, nwg, G, c;
    __host__ __device__ void init(int M, int N, int G_, int c_) { nM = M / BM; nN = N / BM; nwg = nM * nN; G = G_; c = c_; }
    __host__ __device__ bool next(int i, Unit& u) const {
        const long L = (long)i * G + c; if (L >= nwg) return false;
        int wgid = (int)L; { const int q = nwg / NXCD, r = nwg % NXCD, xcd = wgid % NXCD, off = wgid / NXCD; wgid = (xcd < r ? xcd * (q + 1) : r * (q + 1) + (xcd - r) * q) + off; }
        const int nig = WGM * nN, gid = wgid / nig, fm = gid * WGM, gsz = (nM - fm) < WGM ? (nM - fm) : WGM;
        u.pm = fm + ((wgid % nig) % gsz); u.pn = (wgid % nig) / gsz; return true;
    }
    __device__ __forceinline__ void a_ready(const Unit&) const {}
    __device__ __forceinline__ void done(const Unit&) const {}
};
template <class Epi, class Sched>
__device__ __forceinline__ void gemm_phase(PG8_LAS unsigned char* lds, const Gemm g, const Sched& S, const Epi& E) {
    int tid_l = (int)threadIdx.x; asm volatile("" : "+v"(tid_l));
    const int tid = tid_l, wid = __builtin_amdgcn_readfirstlane(tid >> 6), lane = tid & 63, wr = wid >> 2, wc = wid & 3, fr = lane & 15, fq = lane >> 4;
    const int K = g.K, nt = K / BK;
    unsigned voffA[2], voffB[2];
#pragma unroll
    for (int i = 0; i < 2; ++i) { int R, C; stage_rc(tid * 16 + i * 8192, R, C); const int Rb = Epi::PERM ? ((R & ~31) + perm32(R & 31)) : R;
        voffA[i] = (unsigned)(R * K + C) * 2u; voffB[i] = (unsigned)(Rb * K + C) * 2u; }
    const size_t kstep = (size_t)(BK * 2);
    const size_t hstep = (size_t)HALF * K * 2;
    const size_t tstep = 2 * hstep;
    const unsigned ldsw = (unsigned)wid * 1024u;
    const int aoff = lds_byte(wr * 64 + fr, fq * 8), boff = lds_byte(wc * 32 + fr, fq * 8);
#define PG8_SA(b, h) (((b) * 2 + (h)) * HTB)
#define PG8_SB(b, h) ((4 + (b) * 2 + (h)) * HTB)
#define PG8_STAGE(bufoff, gbase, voff) do { _Pragma("unroll") for (int _i = 0; _i < 2; ++_i) \
        __builtin_amdgcn_global_load_lds((const unsigned*)((const char*)(gbase) + (voff)[_i]), (PG8_LAS unsigned*)(lds + (bufoff) + ldsw + _i * 8192), 16, 0, 0); } while (0)
#define PG8_LDA(dst, b, h) do { _Pragma("unroll") for (int m = 0; m < 4; ++m) _Pragma("unroll") for (int k = 0; k < 2; ++k) dst[m][k] = *(const PG8_LAS bf16x8*)(lds + PG8_SA(b, h) + aoff + m * 2048 + k * 1024); } while (0)
#define PG8_LDB(dst, b, h) do { _Pragma("unroll") for (int n = 0; n < 2; ++n) _Pragma("unroll") for (int k = 0; k < 2; ++k) dst[n][k] = *(const PG8_LAS bf16x8*)(lds + PG8_SB(b, h) + boff + n * 2048 + k * 1024); } while (0)
#define PG8_MMA(ai, bj, At, Bt) do { __builtin_amdgcn_s_setprio(1); _Pragma("unroll") for (int m = 0; m < 4; ++m) _Pragma("unroll") for (int n = 0; n < 2; ++n) _Pragma("unroll") for (int k = 0; k < 2; ++k) \
        acc[ai][bj][m][n] = __builtin_amdgcn_mfma_f32_16x16x32_bf16(Bt[n][k], At[m][k], acc[ai][bj][m][n], 0, 0, 0); __builtin_amdgcn_s_setprio(0); } while (0)
#define PG8_WAIT_V(n) asm volatile("s_waitcnt vmcnt(" #n ")" ::: "memory")
#define PG8_WAIT_L(n) asm volatile("s_waitcnt lgkmcnt(" #n ")" ::: "memory")
#define PG8_BAR __builtin_amdgcn_s_barrier()
#define PG8_SCHED __builtin_amdgcn_sched_barrier(0)
    Unit cur, nxt; int ui = 0;
    if (!S.next(0, cur)) return;
    f32x4 acc[2][2][4][2];
#pragma unroll
    for (int a = 0; a < 2; ++a)
#pragma unroll
        for (int b = 0; b < 2; ++b)
#pragma unroll
            for (int m = 0; m < 4; ++m)
#pragma unroll
                for (int n = 0; n < 2; ++n) acc[a][b][m][n] = (f32x4){0.f, 0.f, 0.f, 0.f};
    bf16x8 At[4][2], B0[2][2], B1[2][2];
    const char* cA = (const char*)g.A + (size_t)cur.pm * tstep; const char* cB = (const char*)g.Bt + (size_t)cur.pn * tstep;
    S.a_ready(cur);
    PG8_STAGE(PG8_SB(0, 0), cB, voffB); PG8_STAGE(PG8_SA(0, 0), cA, voffA); PG8_STAGE(PG8_SB(0, 1), cB + hstep, voffB); PG8_STAGE(PG8_SA(0, 1), cA + hstep, voffA);
    if (wr == 1) PG8_BAR;
    PG8_WAIT_V(4); PG8_BAR;
    PG8_STAGE(PG8_SB(1, 0), cB + kstep, voffB); PG8_STAGE(PG8_SA(1, 0), cA + kstep, voffA); PG8_STAGE(PG8_SB(1, 1), cB + hstep + kstep, voffB);
    PG8_WAIT_V(6); PG8_BAR;
    for (;;) {
        const bool has_next = S.next(ui + 1, nxt);
        const char* nA = has_next ? (const char*)g.A + (size_t)nxt.pm * tstep : cA; const char* nB = has_next ? (const char*)g.Bt + (size_t)nxt.pn * tstep : cB;
        for (int t = 0; t < nt; t += 2) {
            const bool last = (t == nt - 2);
            const char* a1 = cA + (size_t)(t + 1) * kstep;
            const char* a2 = last ? nA : cA + (size_t)(t + 2) * kstep; const char* b2 = last ? nB : cB + (size_t)(t + 2) * kstep;
            const char* a3 = a2 + kstep; const char* b3 = b2 + kstep;
            if (last && has_next) S.a_ready(nxt);
            PG8_LDB(B0, 0, 0); PG8_SCHED; PG8_LDA(At, 0, 0); PG8_STAGE(PG8_SA(1, 1), a1 + hstep, voffA);
            PG8_WAIT_L(8); PG8_BAR; PG8_WAIT_L(0); PG8_MMA(0, 0, At, B0); PG8_BAR; PG8_SCHED;
            PG8_LDB(B1, 0, 1); PG8_STAGE(PG8_SB(0, 0), b2, voffB);
            PG8_BAR; PG8_WAIT_L(0); PG8_MMA(0, 1, At, B1); PG8_BAR;
            PG8_LDA(At, 0, 1); PG8_STAGE(PG8_SA(0, 0), a2, voffA);
            PG8_BAR; PG8_WAIT_L(0); PG8_MMA(1, 0, At, B0); PG8_BAR; PG8_SCHED;
            PG8_STAGE(PG8_SB(0, 1), b2 + hstep, voffB);
            PG8_WAIT_V(6); PG8_BAR; PG8_MMA(1, 1, At, B1); PG8_BAR;
            PG8_LDB(B0, 1, 0); PG8_SCHED; PG8_LDA(At, 1, 0); PG8_STAGE(PG8_SA(0, 1), a2 + hstep, voffA);
            PG8_WAIT_L(8); PG8_BAR; PG8_WAIT_L(0); PG8_MMA(0, 0, At, B0); PG8_BAR; PG8_SCHED;
            PG8_LDB(B1, 1, 1); PG8_STAGE(PG8_SB(1, 0), b3, voffB);
            PG8_BAR; PG8_WAIT_L(0); PG8_MMA(0, 1, At, B1); PG8_BAR;
            PG8_LDA(At, 1, 1); PG8_STAGE(PG8_SA(1, 0), a3, voffA);
            PG8_BAR; PG8_WAIT_L(0); PG8_MMA(1, 0, At, B0); PG8_BAR; PG8_SCHED;
            PG8_STAGE(PG8_SB(1, 1), b3 + hstep, voffB);
            PG8_WAIT_V(6); PG8_BAR; PG8_MMA(1, 1, At, B1); PG8_BAR;
        }
        if constexpr (!Epi::AFTER_DRAIN) { E(acc, cur, wr, wc, fr, fq, ui, lds); S.done(cur); }
        if (!has_next) break;
#pragma unroll
        for (int a = 0; a < 2; ++a)
#pragma unroll
            for (int b = 0; b < 2; ++b)
#pragma unroll
                for (int m = 0; m < 4; ++m)
#pragma unroll
                    for (int n = 0; n < 2; ++n) acc[a][b][m][n] = (f32x4){0.f, 0.f, 0.f, 0.f};
        cur = nxt; cA = nA; cB = nB; ++ui;
    }
    PG8_WAIT_V(0);
    if (wr == 0) PG8_BAR;
    PG8_BAR;
    if constexpr (Epi::AFTER_DRAIN) { E.fused(acc, cur, wr, wc, fr, fq, lds, wid, lane); S.done(cur); }
#undef PG8_SA
#undef PG8_SB
#undef PG8_STAGE
#undef PG8_LDA
#undef PG8_LDB
#undef PG8_MMA
#undef PG8_WAIT_V
#undef PG8_WAIT_L
#undef PG8_BAR
#undef PG8_SCHED
}
}

using pg8::bf16_t; using pg8::bf16x8; using pg8::f32x4; using pg8::u32x4;
typedef unsigned u32x2 __attribute__((ext_vector_type(2)));
typedef float f32x2v __attribute__((ext_vector_type(2)));
typedef short s16x4 __attribute__((ext_vector_type(4)));
#define LAS __attribute__((address_space(3)))
typedef LAS unsigned char* ldsp_t;
__device__ __forceinline__ bf16x8 tr_frag(const LAS bf16_t* tile, int k0, int n0, int fr, int fq) {
    const LAS s16x4* a = (const LAS s16x4*)(tile + (k0 + 8 * fq + (fr >> 2)) * 136 + n0 + 4 * (fr & 3));
    const s16x4 r0 = __builtin_amdgcn_ds_read_tr16_b64_v4i16((LAS s16x4*)a), r1 = __builtin_amdgcn_ds_read_tr16_b64_v4i16((LAS s16x4*)(a + 136));
    return (bf16x8){r0[0], r0[1], r0[2], r0[3], r1[0], r1[1], r1[2], r1[3]};
}

constexpr int DM = 1024, DFF = 2816, SEQ = 4096;
constexpr int MMAIN = 32768, MPAD = 33024;
constexpr int LDPE = 3328, LDPO = 2048;
constexpr int NCH = 65;
constexpr float EPS = 1e-6f;
constexpr int LDS_BYTES = 155648;
constexpr int POOL_SPLIT = 1536;
constexpr int RSTD_TAB_OFF = 131072;

constexpr size_t SZ_UP = (size_t)5632 * 1024 * 2, SZ_DN = (size_t)1024 * 2816 * 2, SZ_INE = (size_t)3328 * 1024 * 2, SZ_SQ = (size_t)1024 * 1024 * 2, SZ_INO = (size_t)2048 * 1024 * 2;
constexpr size_t WA_UP0 = 0, WA_DN0 = WA_UP0 + SZ_UP, WA_UP1 = WA_DN0 + SZ_DN, WA_DN1 = WA_UP1 + SZ_UP, WA_INE = WA_DN1 + SZ_DN, WA_OUTE = WA_INE + SZ_INE, SZ_WA = WA_OUTE + SZ_SQ;
constexpr size_t SZ_XB = (size_t)MPAD * 1024 * 2;
constexpr size_t OFF_X1 = SZ_WA, OFF_Y = OFF_X1 + SZ_XB, OFF_BIG = OFF_Y + SZ_XB, SZ_BIG = (size_t)MPAD * 3328 * 2, OFF_R = OFF_BIG + SZ_BIG, SZ_R = (size_t)48 * 65 * 16384 * 2;
constexpr size_t OFF_HMETA = OFF_R + SZ_R, OFF_ROWSS = OFF_HMETA + (size_t)256 * 1024 * 4, OFF_DEC = OFF_ROWSS + (size_t)MPAD * 16 * 4, OFF_AAGG = OFF_DEC + (size_t)48 * 65 * 128 * 4,
                 OFF_BAGG = OFF_AAGG + (size_t)8 * 65 * 512 * 4, WS_END = OFF_BAGG + (size_t)8 * 65 * 512 * 4;
constexpr size_t OFF_BAR = WS_END;
constexpr size_t OFF_FCNT = WS_END + 16384;
constexpr size_t WB_UP2 = 0, WB_DN2 = WB_UP2 + SZ_UP, WB_UP3 = WB_DN2 + SZ_DN, WB_DN3 = WB_UP3 + SZ_UP, WB_INO = WB_DN3 + SZ_DN, WB_OUTO = WB_INO + SZ_INO;
constexpr size_t OFF_CP = OFF_BIG + (size_t)MPAD * 2048 * 2;

struct Params { const float* in[31]; float* out; unsigned char* ws; int nrep; int pad; };

__device__ __forceinline__ int opaque_tid() { int t = (int)threadIdx.x; asm volatile("" : "+v"(t)); return t; }
__device__ __forceinline__ void lds_sync() { asm volatile("s_waitcnt lgkmcnt(0)\n\ts_barrier" ::: "memory"); }
__device__ __forceinline__ float bf2f(unsigned v) { return __uint_as_float(v << 16); }
__device__ __forceinline__ unsigned pack2_hw(float lo, float hi) { unsigned r; asm("v_cvt_pk_bf16_f32 %0, %1, %2" : "=v"(r) : "v"(lo), "v"(hi)); return r; }
__device__ __forceinline__ unsigned f2bf_sw(float f) { unsigned u = __float_as_uint(f); u += 0x7FFFu + ((u >> 16) & 1u); return u >> 16; }
__device__ __forceinline__ unsigned pack2_sw(float lo, float hi) { return f2bf_sw(lo) | (f2bf_sw(hi) << 16); }
#ifndef HWCVT_MASK
#define HWCVT_MASK 15
#endif
template <int G> __device__ __forceinline__ unsigned pack2g(float lo, float hi) { if ((HWCVT_MASK >> G) & 1) return pack2_hw(lo, hi); else return pack2_sw(lo, hi); }
template <int G> __device__ __forceinline__ unsigned f2bfg(float f) { if ((HWCVT_MASK >> G) & 1) return pack2_hw(f, 0.0f) & 0xffffu; else return f2bf_sw(f); }
#define pack2 pack2g<CVG>
#define f2bf f2bfg<CVG>
#define CVG 0
__device__ __forceinline__ float lo16(unsigned w) { return __uint_as_float(w << 16); }
__device__ __forceinline__ float hi16(unsigned w) { return __uint_as_float(w & 0xffff0000u); }
__device__ __forceinline__ float sigm(float x) { return __builtin_amdgcn_rcpf(1.0f + __expf(-x)); }
__device__ __forceinline__ float silu(float x) { return x * sigm(x); }
__device__ __forceinline__ float gelu_tanh(float x) { const float y = 0.7978845608028654f * (x + 0.044715f * x * x * x); const float t = 1.0f - 2.0f * __builtin_amdgcn_rcpf(1.0f + __expf(2.0f * y)); return 0.5f * x * (1.0f + t); }
__device__ __forceinline__ int row_of(int b, int t) { return t < 16 ? MMAIN + t : b * SEQ + (t - 16); }

__device__ __forceinline__ float row_rstd(const float* rowss, int row, int fq) {
    const f32x4 p = *(const f32x4*)(rowss + (size_t)row * 16 + 4 * fq);
    float s = (p[0] + p[1]) + (p[2] + p[3]);
    s += __shfl_xor(s, 16); s += __shfl_xor(s, 32);
    return rsqrtf(s * (1.0f / 1024.0f) + EPS);
}

struct EpiUp {
    static constexpr bool PERM = false, AFTER_DRAIN = false;
    bf16_t* act; const float* rowss;
    __device__ __forceinline__ void operator()(const f32x4 (&acc)[2][2][4][2], const pg8::Unit& u, int wr, int wc, int fr, int fq, int ui, ldsp_t lds) const {
        const LAS float* rtab = (const LAS float*)(lds + RSTD_TAB_OFF) + ui * 256 + wr * 64 + fr;
        const int row0 = u.pm * 256 + wr * 64 + fr, j0 = u.pn * 128 + wc * 16 + 4 * fq;
#pragma unroll
        for (int ai = 0; ai < 2; ++ai)
#pragma unroll
            for (int m = 0; m < 4; ++m) {
                const int row = row0 + ai * 128 + m * 16; const float rs = rtab[ai * 128 + m * 16]; bf16_t* rp = act + (size_t)row * DFF + j0;
#pragma unroll
                for (int bj = 0; bj < 2; ++bj) {
                    const f32x4 g = acc[ai][bj][m][0] * rs, uu = acc[ai][bj][m][1] * rs; const f32x4 t = g * -1.4426950408889634f;
                    f32x4 e; e[0] = __builtin_amdgcn_exp2f(t[0]); e[1] = __builtin_amdgcn_exp2f(t[1]); e[2] = __builtin_amdgcn_exp2f(t[2]); e[3] = __builtin_amdgcn_exp2f(t[3]);
                    const f32x4 d = e + 1.0f; f32x4 r; r[0] = __builtin_amdgcn_rcpf(d[0]); r[1] = __builtin_amdgcn_rcpf(d[1]); r[2] = __builtin_amdgcn_rcpf(d[2]); r[3] = __builtin_amdgcn_rcpf(d[3]);
                    const f32x4 o = (g * uu) * r;
                    u32x2 w; w.x = pack2(o[0], o[1]); w.y = pack2(o[2], o[3]);
                    *(u32x2*)(rp + bj * 64) = w; }
            }
    }
};
struct EpiIn {
    static constexpr bool PERM = false, AFTER_DRAIN = false;
    bf16_t* P; int ldp; const float* rowss;
    __device__ __forceinline__ void operator()(const f32x4 (&acc)[2][2][4][2], const pg8::Unit& u, int wr, int wc, int fr, int fq, int ui, ldsp_t lds) const {
        const LAS float* rtab = (const LAS float*)(lds + RSTD_TAB_OFF) + ui * 256 + wr * 64 + fr;
        const int row0 = u.pm * 256 + wr * 64 + fr, col0 = u.pn * 256 + wc * 32 + 4 * fq;
#pragma unroll
        for (int ai = 0; ai < 2; ++ai)
#pragma unroll
            for (int m = 0; m < 4; ++m) {
                const int row = row0 + ai * 128 + m * 16; const float rs = rtab[ai * 128 + m * 16]; bf16_t* rp = P + (size_t)row * ldp + col0;
#pragma unroll
                for (int bj = 0; bj < 2; ++bj)
#pragma unroll
                    for (int n = 0; n < 2; ++n) { const f32x4 v = acc[ai][bj][m][n] * rs; u32x2 w; w.x = pack2(v[0], v[1]); w.y = pack2(v[2], v[3]); *(u32x2*)(rp + bj * 128 + n * 16) = w; }
            }
    }
};
struct EpiRes {
    static constexpr bool PERM = false, AFTER_DRAIN = false;
    const float* base; float* h; bf16_t* hb; float* rowss; float alpha;
    __device__ __forceinline__ void operator()(const f32x4 (&acc)[2][2][4][2], const pg8::Unit& u, int wr, int wc, int fr, int fq, int, ldsp_t) const {
        const int row0 = u.pm * 256 + wr * 64 + fr, col0 = u.pn * 256 + wc * 32 + 4 * fq;
#pragma unroll
        for (int ai = 0; ai < 2; ++ai) {
            f32x4 bv[4][2][2];
#pragma unroll
            for (int m = 0; m < 4; ++m)
#pragma unroll
                for (int bj = 0; bj < 2; ++bj)
#pragma unroll
                    for (int n = 0; n < 2; ++n) bv[m][bj][n] = *(const f32x4*)(base + (size_t)(row0 + ai * 128 + m * 16) * 1024 + col0 + bj * 128 + n * 16);
            asm volatile("" ::: "memory");
#pragma unroll
            for (int m = 0; m < 4; ++m) {
                const int row = row0 + ai * 128 + m * 16; const size_t off = (size_t)row * 1024 + col0; float ss = 0.f;
#pragma unroll
                for (int bj = 0; bj < 2; ++bj)
#pragma unroll
                    for (int n = 0; n < 2; ++n) { const size_t o = off + bj * 128 + n * 16; const f32x4 hv = bv[m][bj][n] + alpha * acc[ai][bj][m][n];
                        *(f32x4*)(h + o) = hv; u32x2 w; w.x = pack2(hv[0], hv[1]); w.y = pack2(hv[2], hv[3]); *(u32x2*)(hb + o) = w;
                        ss += (hv[0] * hv[0] + hv[1] * hv[1]) + (hv[2] * hv[2] + hv[3] * hv[3]); }
                ss += __shfl_xor(ss, 16); ss += __shfl_xor(ss, 32);
                if (fq == 0) rowss[(size_t)row * 16 + u.pn * 4 + wc] = ss;
            }
        }
    }
};

struct EpiFinal {
    static constexpr bool PERM = false, AFTER_DRAIN = false;
    const float* base; float* out; float* xch; unsigned* cnt; const float* gain; float alpha;
    __device__ __forceinline__ void operator()(const f32x4 (&acc)[2][2][4][2], const pg8::Unit& u, int wr, int wc, int fr, int fq, int, ldsp_t) const {
        const int row0 = u.pm * 256 + wr * 64 + fr, col0 = u.pn * 256 + wc * 32 + 4 * fq;
        f32x4 (&hw)[2][2][4][2] = const_cast<f32x4 (&)[2][2][4][2]>(acc);
#pragma unroll
        for (int ai = 0; ai < 2; ++ai) {
            f32x4 bv[4][2][2];
#pragma unroll
            for (int m = 0; m < 4; ++m)
#pragma unroll
                for (int bj = 0; bj < 2; ++bj)
#pragma unroll
                    for (int n = 0; n < 2; ++n) bv[m][bj][n] = *(const f32x4*)(base + (size_t)(row0 + ai * 128 + m * 16) * 1024 + col0 + bj * 128 + n * 16);
            asm volatile("" ::: "memory");
#pragma unroll
            for (int m = 0; m < 4; ++m) {
                const int row = row0 + ai * 128 + m * 16; float ss = 0.f;
#pragma unroll
                for (int bj = 0; bj < 2; ++bj)
#pragma unroll
                    for (int n = 0; n < 2; ++n) { const f32x4 h4 = bv[m][bj][n] + alpha * acc[ai][bj][m][n]; hw[ai][bj][m][n] = h4; ss += (h4[0] * h4[0] + h4[1] * h4[1]) + (h4[2] * h4[2] + h4[3] * h4[3]); }
                ss += __shfl_xor(ss, 16); ss += __shfl_xor(ss, 32);
                if (fq == 0) __hip_atomic_store(xch + (size_t)row * 16 + u.pn * 4 + wc, ss, __ATOMIC_RELAXED, __HIP_MEMORY_SCOPE_AGENT);
            }
        }
        asm volatile("s_waitcnt vmcnt(0)" ::: "memory");
        unsigned* cp = cnt + (size_t)(u.pm * 2 + wr) * 16;
        if ((fr | fq) == 0) __hip_atomic_fetch_add(cp, 1u, __ATOMIC_RELAXED, __HIP_MEMORY_SCOPE_AGENT);
        { unsigned sp = 0;
          while ((unsigned)__builtin_amdgcn_readfirstlane(__hip_atomic_load(cp, __ATOMIC_RELAXED, __HIP_MEMORY_SCOPE_AGENT)) < 16u) { __builtin_amdgcn_s_sleep(1); if (++sp > (1u << 18)) break; } }
        asm volatile("" ::: "memory");
        f32x4 gv[2][2];
#pragma unroll
        for (int bj = 0; bj < 2; ++bj)
#pragma unroll
            for (int n = 0; n < 2; ++n) gv[bj][n] = *(const f32x4*)(gain + col0 + bj * 128 + n * 16);
#pragma unroll
        for (int ai = 0; ai < 2; ++ai)
#pragma unroll
            for (int m = 0; m < 4; ++m) {
                const int row = row0 + ai * 128 + m * 16; const float* xp = xch + (size_t)row * 16 + 4 * fq;
                float s = (__hip_atomic_load(xp, __ATOMIC_RELAXED, __HIP_MEMORY_SCOPE_AGENT) + __hip_atomic_load(xp + 1, __ATOMIC_RELAXED, __HIP_MEMORY_SCOPE_AGENT)) + (__hip_atomic_load(xp + 2, __ATOMIC_RELAXED, __HIP_MEMORY_SCOPE_AGENT) + __hip_atomic_load(xp + 3, __ATOMIC_RELAXED, __HIP_MEMORY_SCOPE_AGENT));
                s += __shfl_xor(s, 16); s += __shfl_xor(s, 32);
                const float rs = rsqrtf(s * (1.0f / 1024.0f) + EPS);
#pragma unroll
                for (int bj = 0; bj < 2; ++bj)
#pragma unroll
                    for (int n = 0; n < 2; ++n) *(f32x4*)(out + (size_t)row * 1024 + col0 + bj * 128 + n * 16) = hw[ai][bj][m][n] * rs * gv[bj][n];
            }
    }
};

__device__ __forceinline__ f32x4 mfma16(bf16x8 a, bf16x8 b, f32x4 c) { return __builtin_amdgcn_mfma_f32_16x16x32_bf16(a, b, c, 0, 0, 0); }
template <int MODE, int NS>
__device__ __noinline__ void meta_gemm(ldsp_t lds, const bf16_t* A, const bf16_t* Bt, int ntasks, float* hmeta, bf16_t* outb, int ldo, float alpha) {
    constexpr int K = 256 * NS;
    LAS float* part = (LAS float*)lds;
    LAS float* rs = (LAS float*)(lds + 16384);
    const int tid = opaque_tid(), lane = tid & 63, w = tid >> 6, fr = lane & 15, fq = lane >> 4;
    for (int t = blockIdx.x; t < ntasks; t += gridDim.x) {
        bf16x8 av[NS], bv[NS], bw[MODE == 0 ? NS : 1];
        { const bf16_t* ap = A + (size_t)fr * K + 8 * fq + 32 * w;
          const bf16_t* b0 = Bt + (size_t)((MODE == 0 ? 32 * t : 16 * t) + fr) * K + 8 * fq + 32 * w;
#pragma unroll
          for (int i = 0; i < NS; ++i) { av[i] = *(const bf16x8*)(ap + 256 * i); bv[i] = *(const bf16x8*)(b0 + 256 * i); if (MODE == 0) bw[i] = *(const bf16x8*)(b0 + (size_t)16 * K + 256 * i); } }
        if (MODE != 2) {
#pragma unroll
            for (int rr = 0; rr < 2; ++rr) { const int row = 2 * w + rr; float ss = 0.f;
#pragma unroll
                for (int i = 0; i < 4; ++i) { const f32x4 v = *(const f32x4*)(hmeta + (size_t)row * DM + i * 256 + lane * 4); ss += (v[0] * v[0] + v[1] * v[1]) + (v[2] * v[2] + v[3] * v[3]); }
#pragma unroll
                for (int o = 32; o >= 1; o >>= 1) ss += __shfl_xor(ss, o);
                if (lane == 0) rs[row] = rsqrtf(ss * (1.0f / 1024.0f) + EPS); }
        }
        f32x4 acc0 = {0.f, 0.f, 0.f, 0.f}, acc1 = {0.f, 0.f, 0.f, 0.f};
#pragma unroll
        for (int i = 0; i < NS; ++i) { acc0 = mfma16(av[i], bv[i], acc0); if (MODE == 0) acc1 = mfma16(av[i], bw[i], acc1); }
        *(LAS f32x4*)(part + ((w * 2 + 0) * 64 + lane) * 4) = acc0; if (MODE == 0) *(LAS f32x4*)(part + ((w * 2 + 1) * 64 + lane) * 4) = acc1;
        __syncthreads();
        if (tid < 256) { const int e = tid & 3, ln = tid >> 2; float s0 = 0.f, s1 = 0.f;
#pragma unroll
            for (int ww = 0; ww < 8; ++ww) { s0 += part[((ww * 2 + 0) * 64 + ln) * 4 + e]; if (MODE == 0) s1 += part[((ww * 2 + 1) * 64 + ln) * 4 + e]; }
            const int row = 4 * (ln >> 4) + e, col = 16 * t + (ln & 15);
            if (MODE == 0) { const float r = rs[row]; outb[(size_t)(MMAIN + row) * ldo + col] = (bf16_t)f2bf(silu(s0 * r) * (s1 * r)); }
            else if (MODE == 1) { outb[(size_t)(MMAIN + row) * ldo + col] = (bf16_t)f2bf(s0 * rs[row]); }
            else { const float hv = hmeta[(size_t)row * DM + col] + alpha * s0; hmeta[(size_t)row * DM + col] = hv; outb[(size_t)(MMAIN + row) * ldo + col] = (bf16_t)f2bf(hv); } }
        __syncthreads();
    }
}

#undef CVG
#define CVG 1
__device__ void convT_job(const float* __restrict__ src, int K, int N, const float* __restrict__ gain, bf16_t* __restrict__ dst, int which, ldsp_t) {
    const int tid_ = opaque_tid(); const int lane = tid_ & 63, gw = blockIdx.x * 8 + (tid_ >> 6), nw = gridDim.x * 8;
    const int nnb = N >> 6, ntask = (K >> 5) * nnb;
    float v[32], nv[32];
#define CONVT_LOAD(DST, T) { const float* sp_ = src + (size_t)(((T) / nnb) << 5) * N + (((T) % nnb) << 6) + lane; \
        _Pragma("unroll") for (int i = 0; i < 32; ++i) DST[i] = sp_[(size_t)i * N]; }
    int t = gw;
    if (t < ntask) CONVT_LOAD(v, t)
    while (t < ntask) {
        const int nt = t + nw;
        if (nt < ntask) CONVT_LOAD(nv, nt)
        asm volatile("" ::: "memory");
        const int k0 = (t / nnb) << 5, j = ((t % nnb) << 6) + lane;
        if (gain) {
#pragma unroll
            for (int i = 0; i < 32; i += 4) { const f32x4 g = *(const f32x4*)(gain + k0 + i); v[i] *= g[0]; v[i + 1] *= g[1]; v[i + 2] *= g[2]; v[i + 3] *= g[3]; } }
        const int drow = which < 0 ? j : ((j >> 4) * 32 + which * 16 + (j & 15));
        bf16_t* dp = dst + (size_t)drow * K + k0;
#pragma unroll
        for (int i = 0; i < 32; i += 8) { u32x4 w; w.x = pack2(v[i], v[i + 1]); w.y = pack2(v[i + 2], v[i + 3]); w.z = pack2(v[i + 4], v[i + 5]); w.w = pack2(v[i + 6], v[i + 7]); *(u32x4*)(dp + i) = w; }
#pragma unroll
        for (int i = 0; i < 32; ++i) v[i] = nv[i];
        t = nt;
    }
#undef CONVT_LOAD
}
__device__ void conv_ffn(const Params& p, int l, int second, bf16_t* up, bf16_t* dn, ldsp_t lds) {
    const float* nrm = p.in[second ? 7 : 2] + (size_t)l * DM;
    const float* wg = p.in[second ? 8 : 3] + (size_t)l * DM * DFF; const float* wu = p.in[second ? 9 : 4] + (size_t)l * DM * DFF; const float* wd = p.in[second ? 10 : 5] + (size_t)l * DFF * DM;
    convT_job(wg, DM, DFF, nrm, up, 0, lds); convT_job(wu, DM, DFF, nrm, up, 1, lds); convT_job(wd, DFF, DM, nullptr, dn, -1, lds);
}
__device__ void prep_rows(const Params& p, bf16_t* __restrict__ HB, float* __restrict__ rowss, float* __restrict__ hmeta) {
    const int tid_ = opaque_tid(); const int lane = tid_ & 63, gw = blockIdx.x * 8 + (tid_ >> 6), nw = gridDim.x * 8;
    f32x4 v[4], nv[4];
#define PREP_LOAD(DST, ROW) { const float* src_ = (ROW) < MMAIN ? p.in[0] + (size_t)(ROW) * DM : ((ROW) < MMAIN + 16 ? p.in[1] + (size_t)((ROW) - MMAIN) * DM : nullptr); \
        _Pragma("unroll") for (int i = 0; i < 4; ++i) { DST[i] = (f32x4){0.f, 0.f, 0.f, 0.f}; if (src_) DST[i] = *(const f32x4*)(src_ + i * 256 + lane * 4); } }
    int row = gw;
    if (row < MPAD) PREP_LOAD(v, row)
    while (row < MPAD) {
        const int nrow = row + nw;
        if (nrow < MPAD) PREP_LOAD(nv, nrow)
        float ss = 0.f;
#pragma unroll
        for (int i = 0; i < 4; ++i) { const int col = i * 256 + lane * 4;
            ss += (v[i][0] * v[i][0] + v[i][1] * v[i][1]) + (v[i][2] * v[i][2] + v[i][3] * v[i][3]);
            u32x2 w; w.x = pack2(v[i][0], v[i][1]); w.y = pack2(v[i][2], v[i][3]); *(u32x2*)(HB + (size_t)row * DM + col) = w;
            if (row >= MMAIN) *(f32x4*)(hmeta + (size_t)(row - MMAIN) * DM + col) = v[i]; }
#pragma unroll
        for (int o = 32; o >= 1; o >>= 1) ss += __shfl_xor(ss, o);
        if (lane < 16) rowss[(size_t)row * 16 + lane] = lane == 0 ? ss : 0.f;
#pragma unroll
        for (int i = 0; i < 4; ++i) v[i] = nv[i];
        row = nrow;
    }
#undef PREP_LOAD
}

#undef CVG
#define CVG 2
__device__ void hg_phaseA(const Params& p, const bf16_t* P, bf16_t* states, float* dec, ldsp_t lds) {
    LAS float* Lb = (LAS float*)lds;
    LAS bf16_t* Z = (LAS bf16_t*)(lds + 32768);
    LAS bf16_t* VT = (LAS bf16_t*)(lds + 49152);
    LAS bf16_t* KlT = (LAS bf16_t*)(lds + 49152 + 18432);
    LAS float* Tot = (LAS float*)(lds + 49152 + 36864);
    const int tid = opaque_tid(), lane = tid & 63, w = __builtin_amdgcn_readfirstlane(tid >> 6), fr = lane & 15, fq = lane >> 4;
    const float* lbl = p.in[14];
    const int NIT = 48 * 64;
    float lb6a[6], lb6b[6];
#pragma unroll
    for (int hq = 0; hq < 6; ++hq) { lb6a[hq] = sigm(lbl[128 * hq + 2 * lane] - lbl[768 + 128 * hq + 2 * lane]); lb6b[hq] = sigm(lbl[128 * hq + 2 * lane + 1] - lbl[768 + 128 * hq + 2 * lane + 1]); }
    u32x4 pz[2], pv[2];
#define EA_LOAD(IT) { const int c_ = (IT) & 63, bh_ = (IT) >> 6, b_ = bh_ / 6, h_ = bh_ % 6; \
        _Pragma("unroll") for (int i = 0; i < 2; ++i) { const int idx = tid + 512 * i, s = idx >> 4, c8 = (idx & 15) * 8; const bool valid = c_ > 0 || s < 16; \
            const int row = c_ == 0 ? MMAIN + s : b_ * SEQ + 64 * (c_ - 1) + s; pz[i] = (u32x4){0u, 0u, 0u, 0u}; pv[i] = (u32x4){0u, 0u, 0u, 0u}; \
            if (valid) { pz[i] = *(const u32x4*)(P + (size_t)row * LDPE + 1024 + 128 * h_ + c8); pv[i] = *(const u32x4*)(P + (size_t)row * LDPE + 1792 + 128 * h_ + c8); } } }
    int it = blockIdx.x;
    if (it < NIT) EA_LOAD(it)
    while (it < NIT) {
        const int c = it & 63, bh = it >> 6, h = bh % 6;
#pragma unroll
        for (int i = 0; i < 2; ++i) {
            const int idx = tid + 512 * i, s = idx >> 4, c8 = (idx & 15) * 8;
            *(LAS u32x4*)(Z + s * 128 + c8) = pz[i];
            *(LAS u32x4*)(VT + s * 136 + c8) = pv[i];
        }
        lds_sync();
        const int nit = it + (int)gridDim.x;
        if (nit < NIT) EA_LOAD(nit)
        const float lbA = h == 0 ? lb6a[0] : (h == 1 ? lb6a[1] : (h == 2 ? lb6a[2] : (h == 3 ? lb6a[3] : (h == 4 ? lb6a[4] : lb6a[5]))));
        const float lbB = h == 0 ? lb6b[0] : (h == 1 ? lb6b[1] : (h == 2 ? lb6b[2] : (h == 3 ? lb6b[3] : (h == 4 ? lb6b[4] : lb6b[5]))));
        {
            float runA = 0.f, runB = 0.f;
#pragma unroll
            for (int q = 0; q < 8; ++q) { const int s = 8 * w + q; const bool valid = c > 0 || s < 16; const unsigned zz = *(const LAS unsigned*)(Z + s * 128 + 2 * lane);
                const float sgA = sigm(lo16(zz)), sgB = sigm(hi16(zz)); const float fA = lbA + (1.0f - lbA) * sgA, fB = lbB + (1.0f - lbB) * sgB;
                runA += valid ? __logf(fA) : 0.f; runB += valid ? __logf(fB) : 0.f;
                *(LAS f32x2v*)(Lb + s * 128 + 2 * lane) = (f32x2v){runA, runB};
                *(LAS unsigned*)(Z + s * 128 + 2 * lane) = pack2(valid ? (1.0f - lbA) * (1.0f - sgA) : 0.f, valid ? (1.0f - lbB) * (1.0f - sgB) : 0.f); }
            *(LAS f32x2v*)(Tot + w * 128 + 2 * lane) = (f32x2v){runA, runB};
        }
        lds_sync();
        {
            f32x2v T[8];
#pragma unroll
            for (int g = 0; g < 8; ++g) T[g] = *(const LAS f32x2v*)(Tot + g * 128 + 2 * lane);
            f32x2v tail = {0.f, 0.f};
#pragma unroll
            for (int g = 7; g >= 0; --g) { if (g > w) tail += T[g]; }
            f32x2v mine = {0.f, 0.f};
#pragma unroll
            for (int g = 0; g < 8; ++g) { if (g == w) mine = T[g]; }
            float klA[8], klB[8];
#pragma unroll
            for (int q = 0; q < 8; ++q) { const int s = 8 * w + q; const unsigned kz = *(const LAS unsigned*)(Z + s * 128 + 2 * lane); const f32x2v lc = *(const LAS f32x2v*)(Lb + s * 128 + 2 * lane);
                klA[q] = lo16(kz) * __expf(tail[0] + (mine[0] - lc[0])); klB[q] = hi16(kz) * __expf(tail[1] + (mine[1] - lc[1])); }
            u32x4 wA = {pack2(klA[0], klA[1]), pack2(klA[2], klA[3]), pack2(klA[4], klA[5]), pack2(klA[6], klA[7])}, wB = {pack2(klB[0], klB[1]), pack2(klB[2], klB[3]), pack2(klB[4], klB[5]), pack2(klB[6], klB[7])};
            *(LAS u32x4*)(KlT + (2 * lane) * 72 + 8 * w) = wA; *(LAS u32x4*)(KlT + (2 * lane + 1) * 72 + 8 * w) = wB;
            if (w == 0) { f32x2v bl = {0.f, 0.f};
#pragma unroll
                for (int g = 0; g < 8; ++g) bl += T[g];
                *(f32x2v*)(dec + ((size_t)bh * NCH + c) * 128 + 2 * lane) = (f32x2v){__expf(bl[0]), __expf(bl[1])}; }
        }
        lds_sync();
        {
            f32x4 acc[8];
#pragma unroll
            for (int vb = 0; vb < 8; ++vb) acc[vb] = (f32x4){0.f, 0.f, 0.f, 0.f};
#pragma unroll
            for (int kk = 0; kk < 2; ++kk) {
                const bf16x8 a = *(const LAS bf16x8*)(KlT + (16 * w + fr) * 72 + 32 * kk + 8 * fq);
#pragma unroll
                for (int vb = 0; vb < 8; ++vb) { const bf16x8 bb = tr_frag(VT, 32 * kk, 16 * vb, fr, fq); acc[vb] = mfma16(a, bb, acc[vb]); }
            }
            bf16_t* st = states + ((size_t)bh * NCH + c) * 16384;
            float one = 1.0f; asm volatile("" : "+v"(one));
#pragma unroll
            for (int vb = 0; vb < 8; ++vb) { const f32x4 av = acc[vb] * one; u32x2 o; o.x = pack2(av[0], av[1]); o.y = pack2(av[2], av[3]); *(u32x2*)(st + (16 * vb + fr) * 128 + 16 * w + 4 * fq) = o; }
        }
        lds_sync();
        it = nit;
    }
#undef EA_LOAD
}

__device__ void hg_phaseB(bf16_t* __restrict__ states, const float* __restrict__ dec) {
    const int idx = blockIdx.x * 512 + opaque_tid();
    if (idx >= 48 * 2048) return;
    const int bh = idx >> 11, e8 = idx & 2047, k0 = (e8 & 15) * 8;
    bf16_t* sp = states + (size_t)bh * NCH * 16384 + (size_t)e8 * 8; const float* dp = dec + (size_t)bh * NCH * 128 + k0;
    float S[8];
#pragma unroll
    for (int e = 0; e < 8; ++e) S[e] = 0.f;
    u32x4 u[4], nu[4]; f32x4 d0[4], d1[4], nd0[4], nd1[4];
#pragma unroll
    for (int j = 0; j < 4; ++j) { u[j] = *(const u32x4*)(sp + (size_t)j * 16384); d0[j] = *(const f32x4*)(dp + j * 128); d1[j] = *(const f32x4*)(dp + j * 128 + 4); }
    for (int c0 = 0; c0 < 64; c0 += 4) {
        if (c0 + 4 < 64) {
#pragma unroll
            for (int j = 0; j < 4; ++j) { nu[j] = *(const u32x4*)(sp + (size_t)(c0 + 4 + j) * 16384); nd0[j] = *(const f32x4*)(dp + (c0 + 4 + j) * 128); nd1[j] = *(const f32x4*)(dp + (c0 + 4 + j) * 128 + 4); }
        }
#pragma unroll
        for (int j = 0; j < 4; ++j) {
            u32x4 o; o.x = pack2(S[0], S[1]); o.y = pack2(S[2], S[3]); o.z = pack2(S[4], S[5]); o.w = pack2(S[6], S[7]);
            *(u32x4*)(sp + (size_t)(c0 + j) * 16384) = o;
            S[0] = d0[j][0] * S[0] + lo16(u[j].x); S[1] = d0[j][1] * S[1] + hi16(u[j].x); S[2] = d0[j][2] * S[2] + lo16(u[j].y); S[3] = d0[j][3] * S[3] + hi16(u[j].y);
            S[4] = d1[j][0] * S[4] + lo16(u[j].z); S[5] = d1[j][1] * S[5] + hi16(u[j].z); S[6] = d1[j][2] * S[6] + lo16(u[j].w); S[7] = d1[j][3] * S[7] + hi16(u[j].w);
        }
#pragma unroll
        for (int j = 0; j < 4; ++j) { u[j] = nu[j]; d0[j] = nd0[j]; d1[j] = nd1[j]; }
    }
    u32x4 o; o.x = pack2(S[0], S[1]); o.y = pack2(S[2], S[3]); o.z = pack2(S[4], S[5]); o.w = pack2(S[6], S[7]);
    *(u32x4*)(sp + (size_t)64 * 16384) = o;
}

__device__ void hg_phaseC(const Params& p, const bf16_t* P, const bf16_t* states, bf16_t* Y, ldsp_t lds) {
    LAS float* Lb = (LAS float*)lds;
    LAS bf16_t* Z = (LAS bf16_t*)(lds + 32768);
    LAS bf16_t* Qb = (LAS bf16_t*)(lds + 49152);
    LAS bf16_t* Qd = (LAS bf16_t*)(lds + 66560);
    LAS bf16_t* Kd = (LAS bf16_t*)(lds + 83968);
    LAS bf16_t* VT = (LAS bf16_t*)(lds + 127488);
    LAS bf16_t* Am = (LAS bf16_t*)(lds + 145920);
    LAS float* Tot = (LAS float*)(lds + 145920);
    LAS float* O = (LAS float*)lds;
    const int tid = opaque_tid(), lane = tid & 63, w = __builtin_amdgcn_readfirstlane(tid >> 6), fr = lane & 15, fq = lane >> 4;
    const float* lbl = p.in[14]; const float* gnorm = p.in[15];
    const int NIT = 48 * NCH;
    float lb6a[6], lb6b[6];
#pragma unroll
    for (int hq = 0; hq < 6; ++hq) { lb6a[hq] = sigm(lbl[128 * hq + 2 * lane] - lbl[768 + 128 * hq + 2 * lane]); lb6b[hq] = sigm(lbl[128 * hq + 2 * lane + 1] - lbl[768 + 128 * hq + 2 * lane + 1]); }
    u32x4 pq[2], pz[2], pv[2];
#define EC_SKIP(IT) (((IT) % NCH) == 0 && ((IT) / NCH) >= 6)
#define EC_LOAD(IT) { const int c_ = (IT) % NCH, bh_ = (IT) / NCH, b_ = bh_ / 6, h_ = bh_ % 6; \
        _Pragma("unroll") for (int i = 0; i < 2; ++i) { const int idx = tid + 512 * i, s = idx >> 4, c8 = (idx & 15) * 8; const bool valid = c_ > 0 || s < 16; \
            const int row = c_ == 0 ? MMAIN + s : b_ * SEQ + 64 * (c_ - 1) + s; pq[i] = (u32x4){0u, 0u, 0u, 0u}; pz[i] = (u32x4){0u, 0u, 0u, 0u}; pv[i] = (u32x4){0u, 0u, 0u, 0u}; \
            if (valid) { const bf16_t* pr = P + (size_t)row * LDPE + 128 * h_ + c8; pq[i] = *(const u32x4*)(pr + 256); pz[i] = *(const u32x4*)(pr + 1024); pv[i] = *(const u32x4*)(pr + 1792); } } }
    int it = blockIdx.x;
    while (it < NIT && EC_SKIP(it)) it += (int)gridDim.x;
    if (it < NIT) EC_LOAD(it)
    while (it < NIT) {
        const int c = it % NCH, bh = it / NCH, b = bh / 6, h = bh % 6;
#pragma unroll
        for (int i = 0; i < 2; ++i) {
            const int idx = tid + 512 * i, s = idx >> 4, c8 = (idx & 15) * 8;
            *(LAS u32x4*)(Z + s * 128 + c8) = pz[i]; *(LAS u32x4*)(Qd + s * 136 + c8) = pq[i];
            *(LAS u32x4*)(VT + s * 136 + c8) = pv[i];
        }
        lds_sync();
        int nit = it + (int)gridDim.x;
        while (nit < NIT && EC_SKIP(nit)) nit += (int)gridDim.x;
        const int tb = w >> 1, vb0 = 4 * (w & 1);
        const int tn = tid >> 3, v0 = (tid & 7) * 16; const bool nvalid = c > 0 || tn < 16; const int nrow = c == 0 ? MMAIN + tn : b * SEQ + 64 * (c - 1) + tn;
        f32x4 gnv[4];
#pragma unroll
        for (int i = 0; i < 4; ++i) gnv[i] = *(const f32x4*)(gnorm + v0 + 4 * i);
        u32x4 g0 = {0u, 0u, 0u, 0u}, g1 = {0u, 0u, 0u, 0u};
        if (nvalid) { const bf16_t* gp = P + (size_t)nrow * LDPE + 2560 + 128 * h + v0; g0 = *(const u32x4*)gp; g1 = *(const u32x4*)(gp + 8); }
        const float lbA = h == 0 ? lb6a[0] : (h == 1 ? lb6a[1] : (h == 2 ? lb6a[2] : (h == 3 ? lb6a[3] : (h == 4 ? lb6a[4] : lb6a[5]))));
        const float lbB = h == 0 ? lb6b[0] : (h == 1 ? lb6b[1] : (h == 2 ? lb6b[2] : (h == 3 ? lb6b[3] : (h == 4 ? lb6b[4] : lb6b[5]))));
        {
            float runA = 0.f, runB = 0.f;
#pragma unroll
            for (int q = 0; q < 8; ++q) { const int s = 8 * w + q; const bool valid = c > 0 || s < 16; const unsigned zz = *(const LAS unsigned*)(Z + s * 128 + 2 * lane);
                const float sgA = sigm(lo16(zz)), sgB = sigm(hi16(zz)); const float fA = lbA + (1.0f - lbA) * sgA, fB = lbB + (1.0f - lbB) * sgB;
                runA += valid ? __logf(fA) : 0.f; runB += valid ? __logf(fB) : 0.f;
                *(LAS f32x2v*)(Lb + s * 128 + 2 * lane) = (f32x2v){runA, runB};
                *(LAS unsigned*)(Z + s * 128 + 2 * lane) = pack2(valid ? (1.0f - lbA) * (1.0f - sgA) : 0.f, valid ? (1.0f - lbB) * (1.0f - sgB) : 0.f); }
            *(LAS f32x2v*)(Tot + w * 128 + 2 * lane) = (f32x2v){runA, runB};
        }
        lds_sync();
        {
            f32x2v T[7];
#pragma unroll
            for (int g = 0; g < 7; ++g) T[g] = *(const LAS f32x2v*)(Tot + g * 128 + 2 * lane);
            const f32x2v r1 = T[0] + T[1], r2 = r1 + (T[2] + T[3]), r3 = r2 + (T[4] + T[5]);
            const f32x2v E1 = {__expf(r1[0]), __expf(r1[1])}, E2 = {__expf(r2[0]), __expf(r2[1])}, E3 = {__expf(r3[0]), __expf(r3[1])};
            const f32x2v D12 = {__expf(r2[0] - r1[0]), __expf(r2[1] - r1[1])}, D13 = {__expf(r3[0] - r1[0]), __expf(r3[1] - r1[1])}, D23 = {__expf(r3[0] - r2[0]), __expf(r3[1] - r2[1])};
            const f32x2v one2 = {1.0f, 1.0f};
#pragma unroll
            for (int q = 0; q < 8; ++q) {
                const int s = w + 8 * q; const bool valid = c > 0 || s < 16; constexpr int dummy = 0; (void)dummy;
                const int sub = q >> 1;
                const unsigned kz = *(const LAS unsigned*)(Z + s * 128 + 2 * lane); f32x2v bl = *(const LAS f32x2v*)(Lb + s * 128 + 2 * lane); const unsigned qr = *(const LAS unsigned*)(Qd + s * 136 + 2 * lane);
                if (q & 1) bl += T[q - 1];
                const f32x2v eb = {__expf(bl[0]), __expf(bl[1])}; const f32x2v ieb = {__builtin_amdgcn_rcpf(eb[0]), __builtin_amdgcn_rcpf(eb[1])};
                const f32x2v qv = {valid ? silu(lo16(qr)) : 0.f, valid ? silu(hi16(qr)) : 0.f}; const f32x2v qe = qv * eb; const f32x2v ki = (f32x2v){lo16(kz), hi16(kz)} * ieb;
                const f32x2v Es = sub == 0 ? one2 : (sub == 1 ? E1 : (sub == 2 ? E2 : E3)); const f32x2v qb = qe * Es;
                *(LAS unsigned*)(Qd + s * 136 + 2 * lane) = pack2(qe[0], qe[1]); *(LAS unsigned*)(Qb + s * 136 + 2 * lane) = pack2(qb[0], qb[1]);
                if (sub == 0) { const f32x2v k1 = ki * E1, k2 = ki * E2, k3 = ki * E3;
                    *(LAS unsigned*)(Kd + (0 + s) * 136 + 2 * lane) = pack2(ki[0], ki[1]); *(LAS unsigned*)(Kd + (16 + s) * 136 + 2 * lane) = pack2(k1[0], k1[1]);
                    *(LAS unsigned*)(Kd + (48 + s) * 136 + 2 * lane) = pack2(k2[0], k2[1]); *(LAS unsigned*)(Kd + (96 + s) * 136 + 2 * lane) = pack2(k3[0], k3[1]); }
                else if (sub == 1) { const f32x2v k2 = ki * D12, k3 = ki * D13;
                    *(LAS unsigned*)(Kd + (16 + s) * 136 + 2 * lane) = pack2(ki[0], ki[1]); *(LAS unsigned*)(Kd + (48 + s) * 136 + 2 * lane) = pack2(k2[0], k2[1]); *(LAS unsigned*)(Kd + (96 + s) * 136 + 2 * lane) = pack2(k3[0], k3[1]); }
                else if (sub == 2) { const f32x2v k3 = ki * D23;
                    *(LAS unsigned*)(Kd + (48 + s) * 136 + 2 * lane) = pack2(ki[0], ki[1]); *(LAS unsigned*)(Kd + (96 + s) * 136 + 2 * lane) = pack2(k3[0], k3[1]); }
                else { *(LAS unsigned*)(Kd + (96 + s) * 136 + 2 * lane) = pack2(ki[0], ki[1]); }
            }
        }
        lds_sync();
        bf16x8 sfr[4][4];
        { const bf16_t* st = states + ((size_t)bh * NCH + c) * 16384;
#pragma unroll
          for (int kk = 0; kk < 4; ++kk)
#pragma unroll
              for (int vi = 0; vi < 4; ++vi) sfr[kk][vi] = *(const bf16x8*)(st + (16 * (vb0 + vi) + fr) * 128 + 32 * kk + 8 * fq); }
        if (nit < NIT) EC_LOAD(nit)
        for (int bi = w; bi < 10; bi += 8) {
            const int i = bi >= 6 ? 3 : (bi >= 3 ? 2 : (bi >= 1 ? 1 : 0)); const int j = bi - (i * (i + 1)) / 2; const int offi = i == 0 ? 0 : (i == 1 ? 16 : (i == 2 ? 48 : 96));
            f32x4 acc = {0.f, 0.f, 0.f, 0.f};
#pragma unroll
            for (int kk = 0; kk < 4; ++kk) { const bf16x8 a = *(const LAS bf16x8*)(Qd + (16 * i + fr) * 136 + 32 * kk + 8 * fq); const bf16x8 bb = *(const LAS bf16x8*)(Kd + (offi + 16 * j + fr) * 136 + 32 * kk + 8 * fq); acc = mfma16(a, bb, acc); }
#pragma unroll
            for (int e = 0; e < 4; ++e) { const float v = (j == i && fr > 4 * fq + e) ? 0.f : acc[e]; Am[(16 * i + 4 * fq + e) * 72 + 16 * j + fr] = (bf16_t)f2bf(v); }
        }
        if (w >= 2) { const int zb = w - 2; const int zi = zb < 3 ? 0 : (zb < 5 ? 1 : 2); const int zj = zb < 3 ? zb + 1 : (zb < 5 ? zb - 1 : 3);
#pragma unroll
            for (int e = 0; e < 4; ++e) Am[(16 * zi + 4 * fq + e) * 72 + 16 * zj + fr] = (bf16_t)0; }
        lds_sync();
        {
            f32x4 acc[4];
#pragma unroll
            for (int vi = 0; vi < 4; ++vi) acc[vi] = (f32x4){0.f, 0.f, 0.f, 0.f};
#pragma unroll
            for (int kk = 0; kk < 4; ++kk) { const bf16x8 a = *(const LAS bf16x8*)(Qb + (16 * tb + fr) * 136 + 32 * kk + 8 * fq);
#pragma unroll
                for (int vi = 0; vi < 4; ++vi) acc[vi] = mfma16(a, sfr[kk][vi], acc[vi]); }
#pragma unroll
            for (int kk = 0; kk < 2; ++kk) { const bf16x8 a = *(const LAS bf16x8*)(Am + (16 * tb + fr) * 72 + 32 * kk + 8 * fq);
#pragma unroll
                for (int vi = 0; vi < 4; ++vi) { const bf16x8 bb = tr_frag(VT, 32 * kk, 16 * (vb0 + vi), fr, fq); acc[vi] = mfma16(a, bb, acc[vi]); } }
#pragma unroll
            for (int vi = 0; vi < 4; ++vi)
#pragma unroll
                for (int e = 0; e < 4; ++e) O[(16 * tb + 4 * fq + e) * 132 + 16 * (vb0 + vi) + fr] = acc[vi][e];
        }
        lds_sync();
        {
            f32x4 o[4]; float ss = 0.f;
#pragma unroll
            for (int i = 0; i < 4; ++i) { o[i] = *(const LAS f32x4*)(O + tn * 132 + v0 + 4 * i); ss += (o[i][0] * o[i][0] + o[i][1] * o[i][1]) + (o[i][2] * o[i][2] + o[i][3] * o[i][3]); }
            ss += __shfl_xor(ss, 1); ss += __shfl_xor(ss, 2); ss += __shfl_xor(ss, 4);
            const float rn = rsqrtf(ss * (1.0f / 128.0f) + EPS);
            if (nvalid) {
                const unsigned gw[8] = {g0.x, g0.y, g0.z, g0.w, g1.x, g1.y, g1.z, g1.w}; unsigned ow[8];
#pragma unroll
                for (int i = 0; i < 4; ++i) { const f32x4 gn = gnv[i];
                    const float y0 = o[i][0] * rn * gn[0] * silu(lo16(gw[2 * i])), y1 = o[i][1] * rn * gn[1] * silu(hi16(gw[2 * i])), y2 = o[i][2] * rn * gn[2] * silu(lo16(gw[2 * i + 1])), y3 = o[i][3] * rn * gn[3] * silu(hi16(gw[2 * i + 1]));
                    ow[2 * i] = pack2(y0, y1); ow[2 * i + 1] = pack2(y2, y3); }
                bf16_t* yp = Y + (size_t)nrow * DM + 256 + 128 * h + v0;
                *(u32x4*)yp = (u32x4){ow[0], ow[1], ow[2], ow[3]}; *(u32x4*)(yp + 8) = (u32x4){ow[4], ow[5], ow[6], ow[7]};
            }
        }
        lds_sync();
        it = nit;
    }
#undef EC_LOAD
#undef EC_SKIP
}

__device__ __forceinline__ void pool_items(const float* pw, const float* pscale, const bf16_t* P, bf16_t* Y, ldsp_t lds, int it_first, int it_stride, int it_end) {
    LAS float* U = (LAS float*)lds;
    LAS float* Wp = (LAS float*)(lds + 20224);
    LAS float* Mx = (LAS float*)(lds + 36608);
    const int tid = opaque_tid();
    const int NIT = it_end;
    u32x4 pv[2];
#define POOL_LOAD(IT) { const int g_ = (IT) & 3, bc_ = (IT) >> 2; const int b_ = bc_ == 512 ? 0 : bc_ >> 6, c_ = bc_ == 512 ? 0 : (bc_ & 63) + 1; \
        const int t0_ = c_ == 0 ? 0 : 16 + 64 * (c_ - 1), ntok_ = c_ == 0 ? 16 : 64; \
        _Pragma("unroll") for (int k = 0; k < 2; ++k) { const int idx = tid + 512 * k; const int r = idx >> 3, c8 = (idx & 7) * 8, ta = t0_ - 15 + r; pv[k] = (u32x4){0u, 0u, 0u, 0u}; \
            if (idx < 79 * 8 && ta >= 0 && r < 15 + ntok_) pv[k] = *(const u32x4*)(P + (size_t)row_of(b_, ta) * LDPE + 64 * g_ + c8); } }
    int it = it_first, cur_g = -1; f32x4 ps0 = {0.f, 0.f, 0.f, 0.f}, ps1 = {0.f, 0.f, 0.f, 0.f};
    if (it < NIT) POOL_LOAD(it)
    while (it < NIT) {
        const int g = it & 3, bc = it >> 2; const int b = bc == 512 ? 0 : bc >> 6, c = bc == 512 ? 0 : (bc & 63) + 1;
        const int t0 = c == 0 ? 0 : 16 + 64 * (c - 1), ntok = c == 0 ? 16 : 64, wsz = 2 << g;
#pragma unroll
        for (int k = 0; k < 2; ++k) { const int idx = tid + 512 * k; if (idx < 79 * 8) { const int r = idx >> 3, c8 = (idx & 7) * 8; const u32x4 v = pv[k];
            LAS float* up = U + r * 64 + c8; up[0] = lo16(v.x); up[1] = hi16(v.x); up[2] = lo16(v.y); up[3] = hi16(v.y); up[4] = lo16(v.z); up[5] = hi16(v.z); up[6] = lo16(v.w); up[7] = hi16(v.w); } }
        if (g != cur_g) { cur_g = g; ps0 = *(const f32x4*)(pscale + 64 * g + (tid & 7) * 8); ps1 = *(const f32x4*)(pscale + 64 * g + (tid & 7) * 8 + 4);
#pragma unroll
            for (int i = 0; i < 8; ++i) Wp[tid + 512 * i] = pw[g * 4096 + tid + 512 * i]; }
        lds_sync();
        const int nit = it + it_stride;
        if (nit < NIT) POOL_LOAD(nit)
#pragma unroll
        for (int i = 0; i < 8; ++i) { const int idx = tid + 512 * i, s = idx >> 6, ch = idx & 63, ta = t0 + s; float sum = 0.f;
            for (int j = 0; j < wsz; ++j) sum += U[(s + 15 - j) * 64 + ch];
            const int cnt = (ta + 1) < wsz ? (ta + 1) : wsz; Mx[s * 65 + ch] = sum * __builtin_amdgcn_rcpf((float)cnt) - U[(s + 15) * 64 + ch]; }
        lds_sync();
        { const int s = tid >> 3, d0 = (tid & 7) * 8; f32x4 a0 = {0.f, 0.f, 0.f, 0.f}, a1 = {0.f, 0.f, 0.f, 0.f};
          for (int ch = 0; ch < 64; ++ch) { const float m = Mx[s * 65 + ch]; a0 += m * *(const LAS f32x4*)(Wp + ch * 64 + d0); a1 += m * *(const LAS f32x4*)(Wp + ch * 64 + d0 + 4); }
          if (s < ntok) { a0 *= ps0; a1 *= ps1;
              u32x4 o; o.x = pack2(a0[0], a0[1]); o.y = pack2(a0[2], a0[3]); o.z = pack2(a1[0], a1[1]); o.w = pack2(a1[2], a1[3]);
              *(u32x4*)(Y + (size_t)row_of(b, t0 + s) * DM + 64 * g + d0) = o; } }
        lds_sync();
        it = nit;
    }
#undef POOL_LOAD
}

#undef CVG
#define CVG 3
__device__ void conv_items(const Params& p, const bf16_t* P, bf16_t* Y, ldsp_t lds) {
    LAS float* U = (LAS float*)lds;
    LAS float* Wc = (LAS float*)(lds + 48128);
    LAS float* Cv = (LAS float*)(lds + 64000);
    const int tid = opaque_tid(); const float* cw = p.in[18]; const float* cb = p.in[19]; const float* lg = p.in[20]; const float* lbb = p.in[21];
    const int NIT = 513 * 4;
    u32x4 pa[3], pb[3];
#define CONV_LOAD(IT) { const int g_ = (IT) & 3, bc_ = (IT) >> 2; const int b_ = bc_ == 512 ? 0 : bc_ >> 6, c_ = bc_ == 512 ? 0 : (bc_ & 63) + 1; \
        const int t0_ = c_ == 0 ? 0 : 16 + 64 * (c_ - 1), ntok_ = c_ == 0 ? 16 : 64; \
        _Pragma("unroll") for (int k = 0; k < 3; ++k) { const int idx = tid + 512 * k; const int r = idx >> 4, c8 = (idx & 15) * 8, ta = t0_ - 30 + r; pa[k] = (u32x4){0u, 0u, 0u, 0u}; pb[k] = (u32x4){0u, 0u, 0u, 0u}; \
            if (idx < 94 * 16 && ta >= 0 && r < 30 + ntok_) { const bf16_t* pr = P + (size_t)row_of(b_, ta) * LDPO + 128 * g_ + c8; pa[k] = *(const u32x4*)pr; pb[k] = *(const u32x4*)(pr + 512); } } }
    int it = (int)gridDim.x - 1 - (int)blockIdx.x, cur_g = -1; float cbias = 0.f; f32x4 lgv[4], lbv[4];
#pragma unroll
    for (int i = 0; i < 4; ++i) { lgv[i] = (f32x4){0.f, 0.f, 0.f, 0.f}; lbv[i] = (f32x4){0.f, 0.f, 0.f, 0.f}; }
    if (it < NIT) CONV_LOAD(it)
    while (it < NIT) {
        const int g = it & 3, bc = it >> 2; const int b = bc == 512 ? 0 : bc >> 6, c = bc == 512 ? 0 : (bc & 63) + 1;
        const int t0 = c == 0 ? 0 : 16 + 64 * (c - 1), ntok = c == 0 ? 16 : 64;
#pragma unroll
        for (int k = 0; k < 3; ++k) { const int idx = tid + 512 * k; if (idx < 94 * 16) { const int r = idx >> 4, c8 = (idx & 15) * 8; const u32x4 av = pa[k], bv = pb[k];
            LAS float* up = U + r * 128 + c8;
            up[0] = lo16(av.x) * sigm(lo16(bv.x)); up[1] = hi16(av.x) * sigm(hi16(bv.x)); up[2] = lo16(av.y) * sigm(lo16(bv.y)); up[3] = hi16(av.y) * sigm(hi16(bv.y));
            up[4] = lo16(av.z) * sigm(lo16(bv.z)); up[5] = hi16(av.z) * sigm(hi16(bv.z)); up[6] = lo16(av.w) * sigm(lo16(bv.w)); up[7] = hi16(av.w) * sigm(hi16(bv.w)); } }
        if (g != cur_g) { cur_g = g; for (int idx = tid; idx < 31 * 128; idx += 512) Wc[idx] = cw[(idx >> 7) * 512 + 128 * g + (idx & 127)];
            cbias = cb[128 * g + (tid & 127)];
#pragma unroll
            for (int i = 0; i < 4; ++i) { lgv[i] = *(const f32x4*)(lg + 128 * g + (tid & 7) * 16 + 4 * i); lbv[i] = *(const f32x4*)(lbb + 128 * g + (tid & 7) * 16 + 4 * i); } }
        lds_sync();
        const int nit = it + (int)gridDim.x;
        if (nit < NIT) CONV_LOAD(nit)
        { const int ch = tid & 127, sb = tid >> 7; const float bias = cbias;
          float wr[31];
#pragma unroll
          for (int j = 0; j < 31; ++j) wr[j] = Wc[j * 128 + ch];
          float acc[16];
#pragma unroll
          for (int q = 0; q < 16; ++q) acc[q] = bias;
#pragma unroll
          for (int r = 0; r < 46; ++r) { const float uv = U[(16 * sb + r) * 128 + ch];
#pragma unroll
              for (int q = 0; q < 16; ++q) if (r - q >= 0 && r - q < 31) acc[q] += wr[r - q] * uv; }
#pragma unroll
          for (int q = 0; q < 16; ++q) Cv[(16 * sb + q) * 128 + ch] = acc[q]; }
        lds_sync();
        { const int t = tid >> 3, c0 = (tid & 7) * 16; f32x4 v[4]; float sm = 0.f;
#pragma unroll
          for (int i = 0; i < 4; ++i) { v[i] = *(const LAS f32x4*)(Cv + t * 128 + c0 + 4 * i); sm += (v[i][0] + v[i][1]) + (v[i][2] + v[i][3]); }
          sm += __shfl_xor(sm, 1); sm += __shfl_xor(sm, 2); sm += __shfl_xor(sm, 4);
          const float mu = sm * (1.0f / 128.0f); float sq = 0.f;
#pragma unroll
          for (int i = 0; i < 4; ++i) { v[i] -= mu; sq += (v[i][0] * v[i][0] + v[i][1] * v[i][1]) + (v[i][2] * v[i][2] + v[i][3] * v[i][3]); }
          sq += __shfl_xor(sq, 1); sq += __shfl_xor(sq, 2); sq += __shfl_xor(sq, 4);
          const float rs = rsqrtf(sq * (1.0f / 128.0f) + EPS);
          if (t < ntok) { unsigned ow[8];
#pragma unroll
              for (int i = 0; i < 4; ++i) { const f32x4 un = v[i] * rs * lgv[i] + lbv[i];
                  ow[2 * i] = pack2(silu(un[0]), silu(un[1])); ow[2 * i + 1] = pack2(silu(un[2]), silu(un[3])); }
              bf16_t* yp = Y + (size_t)row_of(b, t0 + t) * DM + 128 * g + c0;
              *(u32x4*)yp = (u32x4){ow[0], ow[1], ow[2], ow[3]}; *(u32x4*)(yp + 8) = (u32x4){ow[4], ow[5], ow[6], ow[7]}; } }
        lds_sync();
        it = nit;
    }
#undef CONV_LOAD
}

__device__ void lru_items(const Params& p, const bf16_t* P, float* hloc, float* cpo, float* aagg, float* bagg, ldsp_t lds) {
    LAS float* XB = (LAS float*)lds;
    LAS float* Uc = (LAS float*)(lds + 17152);
    LAS bf16_t* Ub = (LAS bf16_t*)(lds + 33536);
    LAS bf16_t* WaT = (LAS bf16_t*)(lds + 42752);
    LAS bf16_t* WxT = (LAS bf16_t*)(lds + 51968);
    LAS float* Aa = (LAS float*)(lds + 61184);
    LAS float* Bt = (LAS float*)(lds + 77568);
    LAS float* Ag = (LAS float*)(lds + 93952);
    LAS float* Bg = (LAS float*)(lds + 96000);
    const int tid = opaque_tid(), lane = tid & 63, w = tid >> 6, fr = lane & 15, fq = lane >> 4;
    const float* cw = p.in[22]; const float* cb = p.in[23]; const float* wa = p.in[24]; const float* ba = p.in[25]; const float* wx = p.in[26]; const float* bx = p.in[27]; const float* lam = p.in[28];
    int cur_hh = -1; float lcb = 0.f, lcw[4] = {0.f, 0.f, 0.f, 0.f}, lba[2] = {0.f, 0.f}, lbx[2] = {0.f, 0.f}, lsp[2] = {0.f, 0.f};
    const int NIT = 8 * NCH * 8;
    u32x4 px[2];
#define LRU_LOAD(IT) { const int hh_ = (IT) & 7, bc_ = (IT) >> 3, b_ = bc_ / NCH, c_ = bc_ % NCH; const int t0_ = c_ == 0 ? 0 : 16 + 64 * (c_ - 1), ntok_ = c_ == 0 ? 16 : 64; \
        _Pragma("unroll") for (int k = 0; k < 2; ++k) { const int idx = tid + 512 * k; const int r = idx >> 3, c8 = (idx & 7) * 8, ta = t0_ - 3 + r; px[k] = (u32x4){0u, 0u, 0u, 0u}; \
            if (idx < 67 * 8 && ta >= 0 && r < 3 + ntok_) px[k] = *(const u32x4*)(P + (size_t)row_of(b_, ta) * LDPO + 1024 + 64 * hh_ + c8); } }
    int it = blockIdx.x;
    if (it < NIT) LRU_LOAD(it)
    while (it < NIT) {
        const int hh = it & 7, bc = it >> 3, b = bc / NCH, c = bc % NCH;
        const int t0 = c == 0 ? 0 : 16 + 64 * (c - 1), ntok = c == 0 ? 16 : 64;
#pragma unroll
        for (int k = 0; k < 2; ++k) { const int idx = tid + 512 * k; if (idx < 67 * 8) { const int r = idx >> 3, c8 = (idx & 7) * 8; const u32x4 v = px[k];
            LAS float* up = XB + r * 64 + c8; up[0] = lo16(v.x); up[1] = hi16(v.x); up[2] = lo16(v.y); up[3] = hi16(v.y); up[4] = lo16(v.z); up[5] = hi16(v.z); up[6] = lo16(v.w); up[7] = hi16(v.w); } }
        if (hh != cur_hh) {
            cur_hh = hh;
            { const int chq = tid & 63; lcb = cb[64 * hh + chq];
#pragma unroll
              for (int j = 0; j < 4; ++j) lcw[j] = cw[j * 512 + 64 * hh + chq];
#pragma unroll
              for (int j = 0; j < 2; ++j) { const int o = 16 * (2 * (w & 1) + j) + fr; lba[j] = ba[64 * hh + o]; lbx[j] = bx[64 * hh + o]; lsp[j] = log1pf(__expf(-lam[64 * hh + o])); } }
#pragma unroll
            for (int i = 0; i < 8; ++i) { const int idx = tid + 512 * i, ii = idx >> 6, o = idx & 63; WaT[o * 72 + ii] = (bf16_t)f2bf(wa[hh * 4096 + idx]); WxT[o * 72 + ii] = (bf16_t)f2bf(wx[hh * 4096 + idx]); }
        }
        lds_sync();
        const int nit = it + (int)gridDim.x;
        if (nit < NIT) LRU_LOAD(nit)
#pragma unroll
        for (int i = 0; i < 8; ++i) { const int idx = tid + 512 * i, s = idx >> 6, ch = idx & 63; float u = lcb;
#pragma unroll
            for (int j = 0; j < 4; ++j) u += lcw[j] * XB[(s + j) * 64 + ch];
            Uc[idx] = u; Ub[s * 72 + ch] = (bf16_t)f2bf(u); }
        lds_sync();
        {
            const int sbk = w >> 1, ob0 = 2 * (w & 1);
            f32x4 accA[2], accX[2];
#pragma unroll
            for (int j = 0; j < 2; ++j) { accA[j] = (f32x4){0.f, 0.f, 0.f, 0.f}; accX[j] = (f32x4){0.f, 0.f, 0.f, 0.f}; }
#pragma unroll
            for (int kk = 0; kk < 2; ++kk) { const bf16x8 a = *(const LAS bf16x8*)(Ub + (16 * sbk + fr) * 72 + 32 * kk + 8 * fq);
#pragma unroll
                for (int j = 0; j < 2; ++j) { const bf16x8 b1 = *(const LAS bf16x8*)(WaT + (16 * (ob0 + j) + fr) * 72 + 32 * kk + 8 * fq), b2 = *(const LAS bf16x8*)(WxT + (16 * (ob0 + j) + fr) * 72 + 32 * kk + 8 * fq);
                    accA[j] = mfma16(a, b1, accA[j]); accX[j] = mfma16(a, b2, accX[j]); } }
#pragma unroll
            for (int j = 0; j < 2; ++j) { const int o = 16 * (ob0 + j) + fr; const float bao = lba[j], bxo = lbx[j]; const float sp = lsp[j];
#pragma unroll
                for (int e = 0; e < 4; ++e) { const int s = 16 * sbk + 4 * fq + e; const bool valid = s < ntok; const bool first = (t0 + s) == 0;
                    const float rr = sigm(accA[j][e] + bao), ig = sigm(accX[j][e] + bxo); const float la = -8.0f * rr * sp; const float a = __expf(la); const float x2 = 2.0f * la; const float m2 = x2 > -0.05f ? -x2 * (1.0f + x2 * (0.5f + x2 * (0.16666667f + x2 * 0.041666668f))) : 1.0f - a * a; const float mult = __builtin_amdgcn_sqrtf(m2);
                    const float bt = (first ? 1.0f : mult) * ig * Uc[s * 64 + o];
                    Aa[s * 64 + o] = valid ? a : 1.0f; Bt[s * 64 + o] = valid ? bt : 0.f; } }
        }
        lds_sync();
        const int ch = tid & 63, sb = tid >> 6;
        { float cp = 1.0f, hv = 0.f;
#pragma unroll
          for (int q = 0; q < 8; ++q) { const int s = 8 * sb + q; const float a = Aa[s * 64 + ch], bt = Bt[s * 64 + ch]; hv = a * hv + bt; cp *= a; Aa[s * 64 + ch] = cp; Bt[s * 64 + ch] = hv; }
          Ag[sb * 64 + ch] = cp; Bg[sb * 64 + ch] = hv; }
        lds_sync();
        { float carry = 0.f, cpin = 1.0f;
          for (int q = 0; q < sb; ++q) { const float a = Ag[q * 64 + ch]; carry = a * carry + Bg[q * 64 + ch]; cpin *= a; }
          float hl = 0.f, cf = 1.0f;
#pragma unroll
          for (int q = 0; q < 8; ++q) { const int s = 8 * sb + q; hl = Bt[s * 64 + ch] + Aa[s * 64 + ch] * carry; cf = Aa[s * 64 + ch] * cpin;
              if (s < ntok && (c > 0 || b == 0)) { const size_t o = (size_t)row_of(b, t0 + s) * 512 + 64 * hh + ch; hloc[o] = hl; cpo[o] = cf; } }
          if (sb == 7) { aagg[((size_t)b * NCH + c) * 512 + 64 * hh + ch] = cf; bagg[((size_t)b * NCH + c) * 512 + 64 * hh + ch] = hl; } }
        lds_sync();
        it = nit;
    }
#undef LRU_LOAD
}

__device__ void lru_combine(const bf16_t* P, const float* hloc, const float* cpo, const float* aagg, const float* bagg, bf16_t* Y, ldsp_t lds) {
    LAS float* Cr = (LAS float*)lds;
    const int tid = opaque_tid(), lane = tid & 63, w = tid >> 6;
    for (int bc = blockIdx.x; bc < 513; bc += gridDim.x) {
        const int b = bc == 512 ? 0 : bc >> 6, c = bc == 512 ? 0 : (bc & 63) + 1;
        const int t0 = c == 0 ? 0 : 16 + 64 * (c - 1), ntok = c == 0 ? 16 : 64;
        { float carry = 0.f; const float* ap = aagg + (size_t)b * NCH * 512 + tid; const float* bp = bagg + (size_t)b * NCH * 512 + tid;
          int q = 0;
          for (; q + 8 <= c; q += 8) { float a[8], bb[8];
#pragma unroll
              for (int j = 0; j < 8; ++j) { a[j] = ap[(q + j) * 512]; bb[j] = bp[(q + j) * 512]; }
#pragma unroll
              for (int j = 0; j < 8; ++j) carry = a[j] * carry + bb[j]; }
          for (; q < c; ++q) carry = ap[q * 512] * carry + bp[q * 512];
          Cr[tid] = carry; }
        lds_sync();
        const f32x4 c0 = *(const LAS f32x4*)(Cr + lane * 8), c1 = *(const LAS f32x4*)(Cr + lane * 8 + 4);
        for (int s0 = w; s0 < ntok; s0 += 32) {
            f32x4 h0[4], h1[4], p0[4], p1[4]; u32x4 g[4];
#pragma unroll
            for (int k = 0; k < 4; ++k) { const int s = s0 + 8 * k; if (s < ntok) { const size_t row = (size_t)row_of(b, t0 + s);
                h0[k] = *(const f32x4*)(hloc + row * 512 + lane * 8); h1[k] = *(const f32x4*)(hloc + row * 512 + lane * 8 + 4);
                p0[k] = *(const f32x4*)(cpo + row * 512 + lane * 8); p1[k] = *(const f32x4*)(cpo + row * 512 + lane * 8 + 4);
                g[k] = *(const u32x4*)(P + row * LDPO + 1536 + lane * 8); } }
            asm volatile("" ::: "memory");
#pragma unroll
            for (int k = 0; k < 4; ++k) { const int s = s0 + 8 * k; if (s < ntok) { const size_t row = (size_t)row_of(b, t0 + s);
                const f32x4 v0 = h0[k] + p0[k] * c0, v1 = h1[k] + p1[k] * c1; u32x4 o;
                o.x = pack2(gelu_tanh(lo16(g[k].x)) * v0[0], gelu_tanh(hi16(g[k].x)) * v0[1]); o.y = pack2(gelu_tanh(lo16(g[k].y)) * v0[2], gelu_tanh(hi16(g[k].y)) * v0[3]);
                o.z = pack2(gelu_tanh(lo16(g[k].z)) * v1[0], gelu_tanh(hi16(g[k].z)) * v1[1]); o.w = pack2(gelu_tanh(lo16(g[k].w)) * v1[2], gelu_tanh(hi16(g[k].w)) * v1[3]);
                *(u32x4*)(Y + row * DM + 512 + lane * 8) = o; } }
        }
        lds_sync();
    }
}

__device__ void final_norm(float* H, const float* __restrict__ fn) {
    const int tid_ = opaque_tid(); const int lane = tid_ & 63, gw = blockIdx.x * 8 + (tid_ >> 6), nw = gridDim.x * 8;
    f32x4 g[4];
#pragma unroll
    for (int i = 0; i < 4; ++i) g[i] = *(const f32x4*)(fn + i * 256 + lane * 4);
    f32x4 v[4], nv[4];
    int row = gw;
    if (row < MMAIN) {
#pragma unroll
        for (int i = 0; i < 4; ++i) v[i] = *(const f32x4*)(H + (size_t)row * DM + i * 256 + lane * 4); }
    while (row < MMAIN) {
        const int nrow = row + nw;
        if (nrow < MMAIN) {
#pragma unroll
            for (int i = 0; i < 4; ++i) nv[i] = *(const f32x4*)(H + (size_t)nrow * DM + i * 256 + lane * 4); }
        asm volatile("" ::: "memory");
        float ss = 0.f;
#pragma unroll
        for (int i = 0; i < 4; ++i) ss += (v[i][0] * v[i][0] + v[i][1] * v[i][1]) + (v[i][2] * v[i][2] + v[i][3] * v[i][3]);
#pragma unroll
        for (int o = 32; o >= 1; o >>= 1) ss += __shfl_xor(ss, o);
        const float rs = rsqrtf(ss * (1.0f / 1024.0f) + EPS);
#pragma unroll
        for (int i = 0; i < 4; ++i) *(f32x4*)(H + (size_t)row * DM + i * 256 + lane * 4) = v[i] * rs * g[i];
#pragma unroll
        for (int i = 0; i < 4; ++i) v[i] = nv[i];
        row = nrow;
    }
}

#define XB_TMO      128
#define XB_XCNT(j)  (256  + 64 * (j))
#define XB_XSUB(j)  (1280 + 64 * (j))
#define XB_XGEN(j)  (2304 + 64 * (j))
#define XB_TOP      3328
#define XB_TOPGEN   3392
#define XCD_BAR_WORDS 3456
#define XB_SPIN_CAP (1u << 18)

__device__ __forceinline__ unsigned xb_ld(unsigned* p)              { return __hip_atomic_load(p, __ATOMIC_RELAXED, __HIP_MEMORY_SCOPE_AGENT); }
__device__ __forceinline__ unsigned xb_add(unsigned* p, unsigned v) { return __hip_atomic_fetch_add(p, v, __ATOMIC_RELAXED, __HIP_MEMORY_SCOPE_AGENT); }
__device__ __forceinline__ unsigned xb_xcc_id() { return (unsigned)__builtin_amdgcn_s_getreg((3 << 11) | 20) & 0xFu; }
#define XB_SPIN(cond, bar) do { unsigned _sp = 0; while (cond) { __builtin_amdgcn_s_sleep(1); \
    if ((++_sp & 255u) == 0u) { if (xb_ld(&(bar)[XB_TMO])) break; if (_sp > XB_SPIN_CAP) { atomicAdd(&(bar)[XB_TMO], 1u); break; } } } } while (0)

struct XcdBarrier {
    unsigned* bar; unsigned x;
    volatile LAS unsigned* st;
};

__device__ __forceinline__ XcdBarrier xcd_barrier_post(unsigned* bar, volatile LAS unsigned* st) {
    XcdBarrier b; b.bar = bar; b.x = xb_xcc_id(); b.st = st;
    if (threadIdx.x == 0) { const unsigned slot = xb_add(&bar[XB_XCNT(b.x)], 1u); st[2] = slot * 8u + b.x; }
    return b;
}
__device__ __forceinline__ void xcd_barrier_complete(unsigned* bar, unsigned x, unsigned& nloc, unsigned& nx) {
    const unsigned G = gridDim.x * gridDim.y * gridDim.z;
    unsigned sum, cnt, mine, sp = 0u;
    for (;;) {
        sum = 0u; cnt = 0u; mine = 0u;
#pragma unroll
        for (unsigned j = 0; j < 16; ++j) { const unsigned c = xb_ld(&bar[XB_XCNT(j)]); sum += c; cnt += (c > 0u) ? 1u : 0u; mine = (j == x) ? c : mine; }
        if (sum == G) break;
        __builtin_amdgcn_s_sleep(1);
        if ((++sp & 255u) == 0u) { if (xb_ld(&bar[XB_TMO])) break; if (sp > XB_SPIN_CAP) { atomicAdd(&bar[XB_TMO], 1u); break; } }
    }
    nloc = mine > 0u ? mine : 1u; nx = cnt > 0u ? cnt : 1u;
}

__device__ __noinline__ void xcd_barrier(const XcdBarrier b) {
    asm volatile("s_waitcnt vmcnt(0)" ::: "memory");
    __syncthreads();
    if (threadIdx.x == 0) {
        unsigned* bar = b.bar;
        __builtin_amdgcn_s_waitcnt(0);
        unsigned nloc = b.st[0], nx = b.st[1];
        if (nloc == 0u) { xcd_barrier_complete(bar, b.x, nloc, nx); b.st[0] = nloc; b.st[1] = nx; }
        const unsigned old = xb_add(&bar[XB_XSUB(b.x)], 1u);
        const unsigned gen = old / nloc;
        if (old + 1u == (gen + 1u) * nloc) {
            __builtin_amdgcn_fence(__ATOMIC_RELEASE, "agent");
            asm volatile("s_waitcnt vmcnt(0)" ::: "memory");
            const unsigned og = xb_add(&bar[XB_TOP], 1u);
            const unsigned tg = og / nx;
            if (og + 1u == (tg + 1u) * nx) xb_add(&bar[XB_TOPGEN], 1u);
            else XB_SPIN(xb_ld(&bar[XB_TOPGEN]) == tg, bar);
            __builtin_amdgcn_fence(__ATOMIC_ACQUIRE, "agent");
            xb_add(&bar[XB_XGEN(b.x)], 1u);
            asm volatile("s_waitcnt vmcnt(0)" ::: "memory");
        } else {
            XB_SPIN(xb_ld(&bar[XB_XGEN(b.x)]) == gen, bar);
            __builtin_amdgcn_fence(__ATOMIC_ACQUIRE, "agent");
            asm volatile("s_waitcnt vmcnt(0)" ::: "memory");
        }
    }
    __syncthreads();
}


#ifdef PROBE_GEMM_L2
struct NullEpi { static constexpr bool PERM = false, AFTER_DRAIN = false; float* sink;
    __device__ __forceinline__ void operator()(const f32x4 (&acc)[2][2][4][2], const pg8::Unit& u, int wr, int wc, int fr, int fq, int, ldsp_t) const {
        float s = 0.f;
#pragma unroll
        for (int ai = 0; ai < 2; ++ai)
#pragma unroll
            for (int bj = 0; bj < 2; ++bj)
#pragma unroll
                for (int m = 0; m < 4; ++m)
#pragma unroll
                    for (int n = 0; n < 2; ++n) s += acc[ai][bj][m][n][0] + acc[ai][bj][m][n][1] + acc[ai][bj][m][n][2] + acc[ai][bj][m][n][3];
        if (s == 123.456f) sink[0] = s; } };
struct ProbeOrder : pg8::StaticOrder { __device__ bool next(int i, pg8::Unit& u) const { const bool ok = pg8::StaticOrder::next(i, u); u.pm = 0; u.pn = 0; return ok; } };
#endif
__device__ __noinline__ void rstd_table(ldsp_t lds, int N, int vcu, const float* rowss) {
    pg8::StaticOrder S; S.init(MMAIN, N, (int)gridDim.x, vcu);
    LAS float* tab = (LAS float*)(lds + RSTD_TAB_OFF);
    const int tid = opaque_tid(); pg8::Unit u;
    for (int i0 = 0; i0 < 12; i0 += 2) { const int i = i0 + (tid >> 8);
        if (S.next(i, u)) { const float* rp = rowss + (size_t)(u.pm * 256 + (tid & 255)) * 16;
            const f32x4 a = *(const f32x4*)rp, b = *(const f32x4*)(rp + 4), c = *(const f32x4*)(rp + 8), d = *(const f32x4*)(rp + 12);
            const f32x4 s4 = (a + b) + (c + d); tab[i * 256 + (tid & 255)] = rsqrtf(((s4[0] + s4[1]) + (s4[2] + s4[3])) * (1.0f / 1024.0f) + EPS); } }
    __syncthreads();
}
template <class Epi> __device__ __forceinline__ void run_gemm(ldsp_t lds, const bf16_t* A, const bf16_t* Bt, int N, int K, const Epi& E, int vcu) {
    pg8::Gemm g{A, Bt, MMAIN, N, K}; pg8::StaticOrder S; S.init(MMAIN, N, (int)gridDim.x, vcu);
    pg8::gemm_phase<Epi, pg8::StaticOrder>(lds, g, S, E);
}

__global__ void __launch_bounds__(512, 2) fwd_megakernel(Params p) {
    extern __shared__ __attribute__((aligned(16))) unsigned char lds_raw[];
    cg::grid_group grid = cg::this_grid();
    ldsp_t lds = (ldsp_t)lds_raw;
    unsigned char* ws = p.ws;
    volatile LAS unsigned* xst = (volatile LAS unsigned*)(lds + 155136);
    if (threadIdx.x < 4) xst[threadIdx.x] = 0u;
    __syncthreads();
    XcdBarrier xb = xcd_barrier_post((unsigned*)(ws + OFF_BAR), xst);
    bf16_t* X1 = (bf16_t*)(ws + OFF_X1); bf16_t* Y = (bf16_t*)(ws + OFF_Y); bf16_t* BIG = (bf16_t*)(ws + OFF_BIG); unsigned char* R = ws + OFF_R;
    float* hmeta = (float*)(ws + OFF_HMETA); float* rowss = (float*)(ws + OFF_ROWSS); float* dec = (float*)(ws + OFF_DEC); float* aagg = (float*)(ws + OFF_AAGG); float* bagg = (float*)(ws + OFF_BAGG);
#ifndef REP_UP
#define REP_UP 1
#endif
#ifndef REP_DOWN
#define REP_DOWN 0
#endif
#ifndef REP_SYNC
#define REP_SYNC 1
#endif
#if REP_SYNC > 1
#define GSYNC() { xcd_barrier(xb); xcd_barrier(xb); }
#else
#define GSYNC() { xcd_barrier(xb); }
#endif
#define GEMM_UP1(WOFF) { meta_gemm<0, 4>(lds, X1 + (size_t)MMAIN * DM, (const bf16_t*)(WOFF), 176, hmeta, BIG, DFF, 0.f); rstd_table(lds, 5632, vcu, rowss); EpiUp eu{BIG, rowss}; run_gemm<EpiUp>(lds, X1, (const bf16_t*)(WOFF), 5632, DM, eu, vcu); }
#if REP_UP > 1
#define GEMM_UP(WOFF) GEMM_UP1(WOFF) GEMM_UP1(WOFF) GSYNC();
#else
#define GEMM_UP(WOFF) GEMM_UP1(WOFF) GSYNC();
#endif
#if REP_DOWN > 0
#define GEMM_DOWN2(WOFF) { EpiRes e2{p.out, p.out, X1, rowss, 0.0f}; run_gemm<EpiRes>(lds, BIG, (const bf16_t*)(WOFF), DM, DFF, e2, vcu); }
#else
#define GEMM_DOWN2(WOFF)
#endif
#define GEMM_DOWN(WOFF, BASEMAIN) { meta_gemm<2, 11>(lds, BIG + (size_t)MMAIN * DFF, (const bf16_t*)(WOFF), 64, hmeta, X1, DM, 0.5f); EpiRes er{BASEMAIN, p.out, X1, rowss, 0.5f}; run_gemm<EpiRes>(lds, BIG, (const bf16_t*)(WOFF), DM, DFF, er, vcu); } GEMM_DOWN2(WOFF) GSYNC();
#define GEMM_OUT(WOFF) { meta_gemm<2, 4>(lds, Y + (size_t)MMAIN * DM, (const bf16_t*)(WOFF), 64, hmeta, X1, DM, 1.0f); EpiRes er{p.out, p.out, X1, rowss, 1.0f}; run_gemm<EpiRes>(lds, Y, (const bf16_t*)(WOFF), DM, DM, er, vcu); } GSYNC();
    conv_ffn(p, 0, 0, (bf16_t*)(ws + WA_UP0), (bf16_t*)(ws + WA_DN0), lds); conv_ffn(p, 0, 1, (bf16_t*)(ws + WA_UP1), (bf16_t*)(ws + WA_DN1), lds);
    convT_job(p.in[11], DM, 3328, p.in[6], (bf16_t*)(ws + WA_INE), -1, lds); convT_job(p.in[16], DM, DM, nullptr, (bf16_t*)(ws + WA_OUTE), -1, lds);
    prep_rows(p, X1, rowss, hmeta);
#ifdef REP_PREP
    prep_rows(p, X1, rowss, hmeta);
#endif
#ifdef REP_P0
    conv_ffn(p, 0, 0, (bf16_t*)(ws + WA_UP0), (bf16_t*)(ws + WA_DN0), lds); conv_ffn(p, 0, 1, (bf16_t*)(ws + WA_UP1), (bf16_t*)(ws + WA_DN1), lds);
    convT_job(p.in[11], DM, 3328, p.in[6], (bf16_t*)(ws + WA_INE), -1, lds); convT_job(p.in[16], DM, DM, nullptr, (bf16_t*)(ws + WA_OUTE), -1, lds);
    prep_rows(p, X1, rowss, hmeta);
#endif
    if (p.nrep == 0x7fffffff) grid.sync();
    GSYNC();
    int vcu = (int)blockIdx.x;
    { unsigned cnts[8];
#pragma unroll
      for (unsigned j = 0; j < 8; ++j) cnts[j] = xb_ld((unsigned*)(ws + OFF_BAR) + XB_XCNT(j));
      bool even = (gridDim.x % 8u) == 0u;
#pragma unroll
      for (unsigned j = 0; j < 8; ++j) even = even & (cnts[j] == gridDim.x / 8u);
      if (even) vcu = (int)xst[2]; }

    GEMM_UP(ws + WA_UP0)
#ifdef PROBE_GEMM_L2
    { pg8::Gemm g{X1, (const bf16_t*)(ws + WA_UP0), MMAIN, 5632, DM}; ProbeOrder S; S.init(MMAIN, 5632, (int)gridDim.x, vcu); NullEpi ne{hmeta}; pg8::gemm_phase<NullEpi, ProbeOrder>(lds, g, S, ne); }
    GSYNC();
#endif
    GEMM_DOWN(ws + WA_DN0, p.in[0])
    { meta_gemm<1, 4>(lds, X1 + (size_t)MMAIN * DM, (const bf16_t*)(ws + WA_INE), 208, hmeta, BIG, LDPE, 0.f); rstd_table(lds, 3328, vcu, rowss); EpiIn ei{BIG, LDPE, rowss}; run_gemm<EpiIn>(lds, X1, (const bf16_t*)(ws + WA_INE), 3328, DM, ei, vcu); } GSYNC();
    hg_phaseA(p, BIG, (bf16_t*)R, dec, lds); pool_items(p.in[12], p.in[13], BIG, Y, lds, (int)blockIdx.x, (int)gridDim.x, POOL_SPLIT);
#ifdef REP_EA
    hg_phaseA(p, BIG, (bf16_t*)R, dec, lds); pool_items(p.in[12], p.in[13], BIG, Y, lds, (int)blockIdx.x, (int)gridDim.x, POOL_SPLIT);
#endif
    GSYNC();
    hg_phaseB((bf16_t*)R, dec);
    {
        const bool g256 = gridDim.x == 256u;
        const int pf = g256 ? (blockIdx.x >= 192u ? POOL_SPLIT + (int)blockIdx.x - 192 : 513 * 4) : POOL_SPLIT + (int)blockIdx.x, ps = g256 ? 64 : (int)gridDim.x;
        pool_items(p.in[12], p.in[13], BIG, Y, lds, pf, ps, 513 * 4);
    }
    GSYNC();
#ifdef REP_EC
    for (int rep_ = 0; rep_ < p.nrep; ++rep_)
#endif
    hg_phaseC(p, BIG, (const bf16_t*)R, Y, lds);
    GSYNC();
    conv_ffn(p, 1, 0, (bf16_t*)(R + WB_UP2), (bf16_t*)(R + WB_DN2), lds); conv_ffn(p, 1, 1, (bf16_t*)(R + WB_UP3), (bf16_t*)(R + WB_DN3), lds);
    convT_job(p.in[17], DM, 2048, p.in[6] + DM, (bf16_t*)(R + WB_INO), -1, lds); convT_job(p.in[29], DM, DM, nullptr, (bf16_t*)(R + WB_OUTO), -1, lds);
#ifdef REP_W1
    conv_ffn(p, 1, 0, (bf16_t*)(R + WB_UP2), (bf16_t*)(R + WB_DN2), lds); conv_ffn(p, 1, 1, (bf16_t*)(R + WB_UP3), (bf16_t*)(R + WB_DN3), lds);
    convT_job(p.in[17], DM, 2048, p.in[6] + DM, (bf16_t*)(R + WB_INO), -1, lds); convT_job(p.in[29], DM, DM, nullptr, (bf16_t*)(R + WB_OUTO), -1, lds);
#endif
    GEMM_OUT(ws + WA_OUTE)
    GEMM_UP(ws + WA_UP1) GEMM_DOWN(ws + WA_DN1, p.out)
    GEMM_UP(R + WB_UP2) GEMM_DOWN(R + WB_DN2, p.out)
    { meta_gemm<1, 4>(lds, X1 + (size_t)MMAIN * DM, (const bf16_t*)(R + WB_INO), 128, hmeta, BIG, LDPO, 0.f); rstd_table(lds, 2048, vcu, rowss); EpiIn ei{BIG, LDPO, rowss}; run_gemm<EpiIn>(lds, X1, (const bf16_t*)(R + WB_INO), 2048, DM, ei, vcu); } GSYNC();
    conv_items(p, BIG, Y, lds); lru_items(p, BIG, (float*)X1, (float*)(ws + OFF_CP), aagg, bagg, lds);
#ifdef REP_OA
    conv_items(p, BIG, Y, lds); lru_items(p, BIG, (float*)X1, (float*)(ws + OFF_CP), aagg, bagg, lds);
#endif
    GSYNC();
    lru_combine(BIG, (const float*)X1, (const float*)(ws + OFF_CP), aagg, bagg, Y, lds); GSYNC();
    GEMM_OUT(R + WB_OUTO)
    GEMM_UP(R + WB_UP3)
    { meta_gemm<2, 11>(lds, BIG + (size_t)MMAIN * DFF, (const bf16_t*)(R + WB_DN3), 64, hmeta, X1, DM, 0.5f);
      EpiFinal ef{p.out, p.out, rowss, (unsigned*)(ws + OFF_FCNT), p.in[30], 0.5f}; run_gemm<EpiFinal>(lds, BIG, (const bf16_t*)(R + WB_DN3), DM, DFF, ef, vcu); }
}

extern "C" void kernel_launch(void* const* d_in, const int* in_sizes, int n_in, void* d_out, int out_size, void* d_ws, size_t ws_size, hipStream_t stream) {
    static int grid_blocks = 0;
    if (!grid_blocks) {
        int dev = 0, cus = 0, per_cu = 0;
        (void)hipGetDevice(&dev);
        (void)hipDeviceGetAttribute(&cus, hipDeviceAttributeMultiprocessorCount, dev);
        (void)hipFuncSetAttribute((const void*)fwd_megakernel, hipFuncAttributeMaxDynamicSharedMemorySize, LDS_BYTES);
        (void)hipOccupancyMaxActiveBlocksPerMultiprocessor(&per_cu, (const void*)fwd_megakernel, 512, LDS_BYTES);
        grid_blocks = cus > 0 ? cus : 256;
        fprintf(stderr, "kernel_launch: cus=%d per_cu=%d grid=%d ws_size=%zu need=%zu n_in=%d\n", cus, per_cu, grid_blocks, ws_size, (size_t)WS_END, n_in);
        if (ws_size < OFF_BAR + 32768 || n_in != 31) { fprintf(stderr, "kernel_launch: workspace too small or wrong input count; nothing launched\n"); grid_blocks = -1; }
    }
    if (grid_blocks < 0) return;
    Params p{};
    for (int i = 0; i < 31; ++i) p.in[i] = (const float*)d_in[i];
    p.out = (float*)d_out; p.ws = (unsigned char*)d_ws; p.nrep = 2; p.pad = 0;
    (void)hipMemsetAsync((unsigned char*)d_ws + OFF_BAR, 0, 32768, stream);
    void* args[] = {&p};
    hipError_t e = hipLaunchCooperativeKernel((const void*)fwd_megakernel, dim3(grid_blocks), dim3(512), args, LDS_BYTES, stream);
    if (e != hipSuccess) fprintf(stderr, "cooperative launch failed: %s (grid %d)\n", hipGetErrorString(e), grid_blocks);
}
```
